# Optimizing an MI355X kernel written in HIP

```python
import jax, jax.numpy as jnp
from jax import lax
import numpy as np

D_MODEL = 1024
BATCH = 16
SEQ = 4096
DEPTH = 4

GRID_W = 64
CTX_LEN = 256
N_EVEN = (DEPTH + 1) // 2
N_ODD = DEPTH // 2
HEAD_DIM = 64
BLK = 128
POOL_WINDOWS = (2, 4, 8, 16)
POOL_GROUPS = 4
POOL_CH = D_MODEL // 2
POOL_GC = POOL_CH // POOL_GROUPS
B_HEADS = (D_MODEL // 2) // HEAD_DIM
B_KV = B_HEADS // 4
WINDOW = 128
AB_IN = POOL_CH + (B_HEADS + 2 * B_KV) * HEAD_DIM
C_HEADS = D_MODEL // HEAD_DIM
C_KV = C_HEADS // 4
C_IN = (C_HEADS + 2 * C_KV) * HEAD_DIM
D_FF = (8 * D_MODEL // 3) // 128 * 128
ROPE_BASE = 10000.0
EPS = 1e-6
NEG = -1e30

kernel_name = "hybrid_pool_window_global_convffn_dit"


def rms_norm(x, g):
    xf = x.astype(jnp.float32)
    y = xf * lax.rsqrt(jnp.mean(xf * xf, axis=-1, keepdims=True) + EPS)
    return (y * g.astype(jnp.float32)).astype(x.dtype)


def rope_tables(T):
    rows = T // GRID_W
    row = jnp.repeat(jnp.arange(rows), GRID_W).astype(jnp.float32)
    col = jnp.tile(jnp.arange(GRID_W), rows).astype(jnp.float32)
    n_freq = HEAD_DIM // 4
    freqs = ROPE_BASE ** (-jnp.arange(n_freq, dtype=jnp.float32) / n_freq)
    ang = jnp.concatenate([row[:, None] * freqs, col[:, None] * freqs], axis=-1)
    return jnp.cos(ang), jnp.sin(ang)


def apply_rope(x, cos, sin):
    half = HEAD_DIM // 2
    T = x.shape[1]
    shp = (1, T) + (1,) * (x.ndim - 3) + (half,)
    c, s = cos.reshape(shp), sin.reshape(shp)
    xf = x.astype(jnp.float32)
    x1, x2 = xf[..., :half], xf[..., half:]
    return jnp.concatenate([x1 * c - x2 * s, x2 * c + x1 * s], axis=-1).astype(x.dtype)


def attend(q, k, v, mask=None, sink=None):
    s = jnp.einsum('bqhgd,bkhd->bhgqk', q, k).astype(jnp.float32) * (HEAD_DIM ** -0.5)
    if mask is not None:
        s = jnp.where(mask, s, NEG)
    m = jnp.max(s, axis=-1, keepdims=True)
    if sink is not None:
        sk = sink.astype(jnp.float32)[None, :, :, None, None]
        m = jnp.maximum(m, sk)
    e = jnp.exp(s - m)
    den = jnp.sum(e, axis=-1, keepdims=True)
    if sink is not None:
        den = den + jnp.exp(sk - m)
    p = (e / den).astype(v.dtype)
    return jnp.einsum('bhgqk,bkhd->bqhgd', p, v)


def windowed_latent_attention(q, k, v, kc, vc, sink):
    B, T = q.shape[:2]
    nb = T // BLK
    pad = ((0, 0), (BLK, BLK), (0, 0), (0, 0))
    kp, vp = jnp.pad(k, pad), jnp.pad(v, pad)
    qi = jnp.arange(BLK)[:, None]
    ki = jnp.arange(3 * BLK)[None, :]
    ctx_ok = jnp.ones((BLK, kc.shape[1]), dtype=bool)

    def block(n):
        start = n * BLK
        qb = lax.dynamic_slice_in_dim(q, start, BLK, axis=1)
        kb = jnp.concatenate([lax.dynamic_slice_in_dim(kp, start, 3 * BLK, axis=1), kc], axis=1)
        vb = jnp.concatenate([lax.dynamic_slice_in_dim(vp, start, 3 * BLK, axis=1), vc], axis=1)
        qpos = start + qi
        kpos = start - BLK + ki
        band = (jnp.abs(qpos - kpos) <= WINDOW) & (kpos >= 0) & (kpos < T)
        mask = jnp.concatenate([band, ctx_ok], axis=1)
        return attend(qb, kb, vb, mask, sink)

    out = lax.map(block, jnp.arange(nb))
    return jnp.moveaxis(out, 0, 1).reshape(B, T, -1)


def global_latent_attention(q, k_all, v_all):
    B, T = q.shape[:2]
    nb = T // BLK

    def block(n):
        qb = lax.dynamic_slice_in_dim(q, n * BLK, BLK, axis=1)
        return attend(qb, k_all, v_all)

    out = lax.map(block, jnp.arange(nb))
    return jnp.moveaxis(out, 0, 1).reshape(B, T, -1)


def pool_mix(u, w, scale):
    B, T = u.shape[:2]
    uf = u.astype(jnp.float32)
    cs = jnp.concatenate([jnp.zeros_like(uf[:, :1]), jnp.cumsum(uf, axis=1)], axis=1)
    t = jnp.arange(T)
    means = []
    for g, win in enumerate(POOL_WINDOWS):
        lo = jnp.clip(t - win // 2, 0, T)
        hi = jnp.clip(t + win // 2, 0, T)
        cnt = (hi - lo).astype(jnp.float32)[None, :, None]
        means.append((cs[:, hi, g] - cs[:, lo, g]) / cnt)
    pooled = jnp.stack(means, axis=2)
    d = (pooled - uf).astype(u.dtype)
    y = jnp.einsum('btgc,gce->btge', d, w).reshape(B, T, POOL_CH)
    return y * scale


def split_ab(p):
    B, T = p.shape[:2]
    o = POOL_CH
    u = p[..., :o].reshape(B, T, POOL_GROUPS, POOL_GC)
    q = p[..., o:o + B_HEADS * HEAD_DIM].reshape(B, T, B_KV, B_HEADS // B_KV, HEAD_DIM)
    o += B_HEADS * HEAD_DIM
    k = p[..., o:o + B_KV * HEAD_DIM].reshape(B, T, B_KV, HEAD_DIM)
    o += B_KV * HEAD_DIM
    v = p[..., o:o + B_KV * HEAD_DIM].reshape(B, T, B_KV, HEAD_DIM)
    return u, q, k, v


def mixer_ab(h, hc, w_in, w_out, pool_w, pool_scale, sink, cos, sin, need_ctx):
    u, q, k, v = split_ab(h @ w_in)
    uc, qc, kc, vc = split_ab(hc @ w_in)
    q, k = apply_rope(q, cos, sin), apply_rope(k, cos, sin)
    a = windowed_latent_attention(q, k, v, kc, vc, sink)
    y = jnp.concatenate([pool_mix(u, pool_w, pool_scale), a], axis=-1) @ w_out
    yc = None
    if need_ctx:
        B, L = hc.shape[:2]
        ac = attend(qc, kc, vc, None, sink).reshape(B, L, -1)
        yc = jnp.concatenate([pool_mix(uc, pool_w, pool_scale), ac], axis=-1) @ w_out
    return y, yc


def split_c(p, q_g, k_g):
    B, T = p.shape[:2]
    o = C_HEADS * HEAD_DIM
    q = p[..., :o].reshape(B, T, C_KV, C_HEADS // C_KV, HEAD_DIM)
    k = p[..., o:o + C_KV * HEAD_DIM].reshape(B, T, C_KV, HEAD_DIM)
    o += C_KV * HEAD_DIM
    v = p[..., o:o + C_KV * HEAD_DIM].reshape(B, T, C_KV, HEAD_DIM)
    return rms_norm(q, q_g), rms_norm(k, k_g), v


def mixer_c(h, hc, w_qkv, w_out, q_g, k_g, cos, sin, need_ctx):
    q, k, v = split_c(h @ w_qkv, q_g, k_g)
    qc, kc, vc = split_c(hc @ w_qkv, q_g, k_g)
    q, k = apply_rope(q, cos, sin), apply_rope(k, cos, sin)
    k_all = jnp.concatenate([k, kc], axis=1)
    v_all = jnp.concatenate([v, vc], axis=1)
    y = global_latent_attention(q, k_all, v_all) @ w_out
    yc = None
    if need_ctx:
        B, L = hc.shape[:2]
        yc = attend(qc, kc, vc).reshape(B, L, -1) @ w_out
    return y, yc


def conv_ffn(h, w_up, conv_w, conv_b, w_down):
    u = h @ w_up
    up = jnp.pad(u, ((0, 0), (1, 1), (0, 0)))
    u = up[:, :-2] * conv_w[0] + up[:, 1:-1] * conv_w[1] + up[:, 2:] * conv_w[2] + conv_b
    a, b = jnp.split(u, 2, axis=-1)
    return (jax.nn.gelu(a) * b) @ w_down


def ada_params(cvec, w, b):
    return jnp.split(jax.nn.silu(cvec) @ w + b, 6, axis=-1)


def pre_mod(x, g, shift, scale):
    return rms_norm(x, g) * (1 + scale) + shift


def post_add(x, y, g, gate):
    return x + gate * rms_norm(y, g)


def setup_inputs(seed: int = 0) -> dict:
    key = jax.random.key(seed)
    ks = jax.random.split(key, 24)
    f32 = jnp.float32
    D = D_MODEL

    def nrm(k, shape, s):
        return jax.random.normal(k, shape, f32) * s

    return {
        "x": nrm(ks[0], (BATCH, SEQ, D), 1.0),
        "c": nrm(ks[1], (BATCH, D), 1.0),
        "ctx": nrm(ks[2], (BATCH, CTX_LEN, D), 1.0),
        "c_ctx": nrm(ks[3], (D,), 1.0),
        "ada_w": nrm(ks[4], (DEPTH, D, 6 * D), 0.5 * D ** -0.5),
        "ada_b": nrm(ks[5], (DEPTH, 6 * D), 0.02),
        "mix_pre_g": 1.0 + nrm(ks[6], (DEPTH, D), 0.02),
        "mix_post_g": 1.0 + nrm(ks[7], (DEPTH, D), 0.02),
        "ffn_pre_g": 1.0 + nrm(ks[8], (DEPTH, D), 0.02),
        "ffn_post_g": 1.0 + nrm(ks[9], (DEPTH, D), 0.02),
        "ab_w_in": nrm(ks[10], (N_EVEN, D, AB_IN), D ** -0.5),
        "ab_w_out": nrm(ks[11], (N_EVEN, POOL_CH + B_HEADS * HEAD_DIM, D), D ** -0.5),
        "pool_w": nrm(ks[12], (N_EVEN, POOL_GROUPS, POOL_GC, POOL_GC), POOL_GC ** -0.5),
        "pool_scale": 1.0 + nrm(ks[13], (N_EVEN, POOL_CH), 0.1),
        "sink_logit": nrm(ks[14], (N_EVEN, B_KV, B_HEADS // B_KV), 0.5),
        "c_w_qkv": nrm(ks[15], (N_ODD, D, C_IN), D ** -0.5),
        "c_w_out": nrm(ks[16], (N_ODD, C_HEADS * HEAD_DIM, D), D ** -0.5),
        "c_q_g": 1.0 + nrm(ks[17], (N_ODD, HEAD_DIM), 0.02),
        "c_k_g": 1.0 + nrm(ks[18], (N_ODD, HEAD_DIM), 0.02),
        "ffn_w_up": nrm(ks[19], (DEPTH, D, 2 * D_FF), D ** -0.5),
        "ffn_conv_w": nrm(ks[20], (DEPTH, 3, 2 * D_FF), 3 ** -0.5),
        "ffn_conv_b": nrm(ks[21], (DEPTH, 2 * D_FF), 0.02),
        "ffn_w_down": nrm(ks[22], (DEPTH, D_FF, D), D_FF ** -0.5),
    }


def reference(x, c, ctx, c_ctx, ada_w, ada_b, mix_pre_g, mix_post_g, ffn_pre_g, ffn_post_g,
              ab_w_in, ab_w_out, pool_w, pool_scale, sink_logit,
              c_w_qkv, c_w_out, c_q_g, c_k_g,
              ffn_w_up, ffn_conv_w, ffn_conv_b, ffn_w_down):
    T = x.shape[1]
    cos, sin = rope_tables(T)
    xc = ctx
    for l in range(DEPTH):
        need_ctx = l < DEPTH - 1
        sh1, sc1, g1, sh2, sc2, g2 = [m[:, None, :] for m in ada_params(c, ada_w[l], ada_b[l])]
        csh1, csc1, cg1, csh2, csc2, cg2 = ada_params(c_ctx, ada_w[l], ada_b[l])
        h = pre_mod(x, mix_pre_g[l], sh1, sc1)
        hc = pre_mod(xc, mix_pre_g[l], csh1, csc1)
        i = l // 2
        if l % 2 == 0:
            y, yc = mixer_ab(h, hc, ab_w_in[i], ab_w_out[i], pool_w[i], pool_scale[i], sink_logit[i],
                             cos, sin, need_ctx)
        else:
            y, yc = mixer_c(h, hc, c_w_qkv[i], c_w_out[i], c_q_g[i], c_k_g[i], cos, sin, need_ctx)
        x = post_add(x, y, mix_post_g[l], g1)
        f = conv_ffn(pre_mod(x, ffn_pre_g[l], sh2, sc2), ffn_w_up[l], ffn_conv_w[l], ffn_conv_b[l], ffn_w_down[l])
        x = post_add(x, f, ffn_post_g[l], g2)
        if need_ctx:
            xc = post_add(xc, yc, mix_post_g[l], cg1)
            fc = conv_ffn(pre_mod(xc, ffn_pre_g[l], csh2, csc2), ffn_w_up[l], ffn_conv_w[l], ffn_conv_b[l], ffn_w_down[l])
            xc = post_add(xc, fc, ffn_post_g[l], cg2)
    return x
```

```cpp
#include <hip/hip_runtime.h>
#include <hip/hip_cooperative_groups.h>
#include <cstdio>
#include <cstdint>
#include <cstring>
namespace cg = cooperative_groups;

#ifndef MULTI_LAUNCH
#define MULTI_LAUNCH 0
#define PROBE_DUP 0
#endif

#ifndef PROBE_DUP
#define PROBE_DUP 0
#endif
#define DI __device__ __forceinline__
#define LAS __attribute__((address_space(3)))
typedef unsigned short bf16_t;
typedef short bf16x8 __attribute__((ext_vector_type(8)));
typedef short s16x4 __attribute__((ext_vector_type(4)));
typedef float f32x16 __attribute__((ext_vector_type(16)));
typedef float f32x4 __attribute__((ext_vector_type(4)));
typedef float f32x2 __attribute__((ext_vector_type(2)));
typedef __bf16 bf16x2_t __attribute__((ext_vector_type(2)));
typedef unsigned u32x2 __attribute__((ext_vector_type(2)));
typedef unsigned u32x4 __attribute__((ext_vector_type(4)));
typedef LAS char lchar;

__device__ __attribute__((aligned(16))) const float ROPE_COS[1024] = {1.00000000e+00f,1.00000000e+00f,1.00000000e+00f,1.00000000e+00f,1.00000000e+00f,1.00000000e+00f,1.00000000e+00f,1.00000000e+00f,1.00000000e+00f,1.00000000e+00f,1.00000000e+00f,1.00000000e+00f,1.00000000e+00f,1.00000000e+00f,1.00000000e+00f,1.00000000e+00f,5.40302277e-01f,8.46009135e-01f,9.50415254e-01f,9.84230220e-01f,9.95004177e-01f,9.98419285e-01f,9.99500036e-01f,9.99841869e-01f,9.99949992e-01f,9.99984205e-01f,9.99994993e-01f,9.99998391e-01f,9.99999523e-01f,9.99999821e-01f,9.99999940e-01f,1.00000000e+00f,-4.16146845e-01f,4.31462824e-01f,8.06578398e-01f,9.37418282e-01f,9.80066597e-01f,9.93682086e-01f,9.98000681e-01f,9.99367595e-01f,9.99800026e-01f,9.99936759e-01f,9.99979973e-01f,9.99993682e-01f,9.99997973e-01f,9.99999344e-01f,9.99999821e-01f,9.99999940e-01f,-9.89992499e-01f,-1.15966164e-01f,5.82753658e-01f,8.61040652e-01f,9.55336511e-01f,9.85803485e-01f,9.95503366e-01f,9.98577297e-01f,9.99550045e-01f,9.99857724e-01f,9.99954998e-01f,9.99985754e-01f,9.99995530e-01f,9.99998569e-01f,9.99999523e-01f,9.99999881e-01f,-6.53643608e-01f,-6.27679706e-01f,3.01137477e-01f,7.57506192e-01f,9.21060979e-01f,9.74808276e-01f,9.92010653e-01f,9.97471273e-01f,9.99200106e-01f,9.99747038e-01f,9.99920011e-01f,9.99974728e-01f,9.99992013e-01f,9.99997497e-01f,9.99999225e-01f,9.99999762e-01f,2.83662200e-01f,-9.46079254e-01f,-1.03423381e-02f,6.30080283e-01f,8.77582550e-01f,9.60731268e-01f,9.87526000e-01f,9.96049762e-01f,9.98750269e-01f,9.99604762e-01f,9.99875009e-01f,9.99960482e-01f,9.99987483e-01f,9.99996066e-01f,9.99998748e-01f,9.99999583e-01f,9.60170269e-01f,-9.73103702e-01f,-3.20796400e-01f,4.82782036e-01f,8.25335622e-01f,9.43616986e-01f,9.82053936e-01f,9.94313300e-01f,9.98200536e-01f,9.99430835e-01f,9.99819994e-01f,9.99943078e-01f,9.99981999e-01f,9.99994338e-01f,9.99998212e-01f,9.99999404e-01f,7.53902256e-01f,-7.00429797e-01f,-5.99437475e-01f,3.20257008e-01f,7.64842212e-01f,9.23519433e-01f,9.75599885e-01f,9.92262423e-01f,9.97551024e-01f,9.99225318e-01f,9.99755025e-01f,9.99922514e-01f,9.99975502e-01f,9.99992251e-01f,9.99997556e-01f,9.99999225e-01f,-1.45500034e-01f,-2.12036446e-01f,-8.18632424e-01f,1.47631213e-01f,6.96706712e-01f,9.00502324e-01f,9.68170285e-01f,9.89897788e-01f,9.96801734e-01f,9.98988271e-01f,9.99680042e-01f,9.99898791e-01f,9.99967992e-01f,9.99989867e-01f,9.99996781e-01f,9.99998987e-01f,-9.11130250e-01f,3.41660261e-01f,-9.56644177e-01f,-2.96507962e-02f,6.21609926e-01f,8.74638259e-01f,9.59772646e-01f,9.87220109e-01f,9.95952725e-01f,9.98719573e-01f,9.99595046e-01f,9.99871910e-01f,9.99959528e-01f,9.99987185e-01f,9.99995947e-01f,9.99998748e-01f,-8.39071512e-01f,7.90131867e-01f,-9.99786079e-01f,-2.05997631e-01f,5.40302277e-01f,8.46009135e-01f,9.50415313e-01f,9.84230220e-01f,9.95004177e-01f,9.98419285e-01f,9.99500036e-01f,9.99841869e-01f,9.99949992e-01f,9.99984205e-01f,9.99994993e-01f,9.99998391e-01f,4.42569796e-03f,9.95257378e-01f,-9.43779767e-01f,-3.75847399e-01f,4.53596085e-01f,8.14705312e-01f,9.40107584e-01f,9.80929136e-01f,9.93956089e-01f,9.98087406e-01f,9.99395072e-01f,9.99808669e-01f,9.99939501e-01f,9.99980867e-01f,9.99993920e-01f,9.99998093e-01f,8.43853951e-01f,8.93861592e-01f,-7.94179380e-01f,-5.33843040e-01f,3.62357706e-01f,7.80825913e-01f,9.28859890e-01f,9.77317870e-01f,9.92808640e-01f,9.97723997e-01f,9.99280095e-01f,9.99772310e-01f,9.99927998e-01f,9.99977231e-01f,9.99992788e-01f,9.99997735e-01f,9.07446802e-01f,5.17172873e-01f,-5.65820515e-01f,-6.75001681e-01f,2.67498761e-01f,7.44477987e-01f,9.16683376e-01f,9.73397553e-01f,9.91561890e-01f,9.97329056e-01f,9.99155104e-01f,9.99732792e-01f,9.99915481e-01f,9.99973297e-01f,9.99991536e-01f,9.99997318e-01f,1.36737213e-01f,-1.87961515e-02f,-2.81349480e-01f,-7.94870913e-01f,1.69967160e-01f,7.05776393e-01f,9.03590262e-01f,9.69169438e-01f,9.90216017e-01f,9.96902585e-01f,9.99020159e-01f,9.99690115e-01f,9.99902010e-01f,9.99969006e-01f,9.99990225e-01f,9.99996901e-01f,-7.59687901e-01f,-5.48975468e-01f,3.10223512e-02f,-8.89670432e-01f,7.07371980e-02f,6.64843500e-01f,8.89593601e-01f,9.64634836e-01f,9.88771081e-01f,9.96444523e-01f,9.98875201e-01f,9.99644279e-01f,9.99887526e-01f,9.99964416e-01f,9.99988735e-01f,9.99996424e-01f,-9.57659483e-01f,-9.10081089e-01f,3.40318173e-01f,-9.56410050e-01f,-2.91995462e-02f,6.21808827e-01f,8.74707460e-01f,9.59795177e-01f,9.87227261e-01f,9.95954990e-01f,9.98720288e-01f,9.99595284e-01f,9.99872029e-01f,9.99959528e-01f,9.99987185e-01f,9.99995947e-01f,-2.75163352e-01f,-9.90897954e-01f,6.15864813e-01f,-9.92985010e-01f,-1.28844544e-01f,5.76808274e-01f,8.58946681e-01f,9.54652011e-01f,9.85584795e-01f,9.95433986e-01f,9.98555362e-01f,9.99543071e-01f,9.99855518e-01f,9.99954283e-01f,9.99985576e-01f,9.99995410e-01f,6.60316706e-01f,-7.66536534e-01f,8.30336154e-01f,-9.98241663e-01f,-2.27202162e-01f,5.29984176e-01f,8.42327058e-01f,9.49207008e-01f,9.83843684e-01f,9.94881511e-01f,9.98380423e-01f,9.99487758e-01f,9.99837995e-01f,9.99948800e-01f,9.99983788e-01f,9.99994874e-01f,9.88704622e-01f,-3.06095392e-01f,9.62463796e-01f,-9.72014248e-01f,-3.23289543e-01f,4.81484592e-01f,8.24865162e-01f,9.43461835e-01f,9.82004225e-01f,9.94297504e-01f,9.98195529e-01f,9.99429286e-01f,9.99819517e-01f,9.99942899e-01f,9.99981940e-01f,9.99994278e-01f,4.08082068e-01f,2.48616725e-01f,9.99144375e-01f,-9.15129960e-01f,-4.16146845e-01f,4.31462824e-01f,8.06578457e-01f,9.37418282e-01f,9.80066597e-01f,9.93682086e-01f,9.98000681e-01f,9.99367595e-01f,9.99800026e-01f,9.99936759e-01f,9.99979973e-01f,9.99993682e-01f,-5.47729254e-01f,7.26760268e-01f,9.36740458e-01f,-8.29382956e-01f,-5.04846215e-01f,3.80077004e-01f,7.87485182e-01f,9.31078374e-01f,9.78030920e-01f,9.93035257e-01f,9.97795820e-01f,9.99302804e-01f,9.99779522e-01f,9.99930263e-01f,9.99977946e-01f,9.99993026e-01f,-9.99960840e-01f,9.81074572e-01f,7.81440377e-01f,-7.17477441e-01f,-5.88501155e-01f,3.27489585e-01f,7.67604589e-01f,9.24443960e-01f,9.75897431e-01f,9.92357016e-01f,9.97581005e-01f,9.99234855e-01f,9.99758005e-01f,9.99923468e-01f,9.99975801e-01f,9.99992371e-01f,-5.32833040e-01f,9.33235765e-01f,5.48645258e-01f,-5.82943261e-01f,-6.66275978e-01f,2.73866832e-01f,7.46956408e-01f,9.17517304e-01f,9.73666370e-01f,9.91647422e-01f,9.97356176e-01f,9.99163687e-01f,9.99735534e-01f,9.99916375e-01f,9.99973536e-01f,9.99991655e-01f,4.24179018e-01f,5.97977161e-01f,2.61441678e-01f,-4.30023283e-01f,-7.37393796e-01f,2.19378278e-01f,7.25561321e-01f,9.10300434e-01f,9.71337974e-01f,9.90906477e-01f,9.97121394e-01f,9.99089420e-01f,9.99711990e-01f,9.99908924e-01f,9.99971211e-01f,9.99990880e-01f,9.91202831e-01f,7.85522610e-02f,-5.16893305e-02f,-2.63540596e-01f,-8.01143587e-01f,1.64196163e-01f,7.03440726e-01f,9.02795732e-01f,9.68912423e-01f,9.90134120e-01f,9.96876657e-01f,9.99011934e-01f,9.99687493e-01f,9.99901175e-01f,9.99968767e-01f,9.99990106e-01f,6.46919310e-01f,-4.65064496e-01f,-3.59694332e-01f,-8.87455046e-02f,-8.56888831e-01f,1.08494945e-01f,6.80616796e-01f,8.95005584e-01f,9.66389954e-01f,9.89330530e-01f,9.96621907e-01f,9.98931348e-01f,9.99662042e-01f,9.99893129e-01f,9.99966204e-01f,9.99989331e-01f,-2.92138815e-01f,-8.65450621e-01f,-6.32028639e-01f,8.88481140e-02f,-9.04072165e-01f,5.24506159e-02f,6.57112300e-01f,8.86932373e-01f,9.63770926e-01f,9.88495648e-01f,9.96357203e-01f,9.98847544e-01f,9.99635518e-01f,9.99884725e-01f,9.99963522e-01f,9.99988496e-01f,-9.62605894e-01f,-9.99293387e-01f,-8.41684937e-01f,2.63639510e-01f,-9.42222297e-01f,-3.75941908e-03f,6.32950664e-01f,8.78578722e-01f,9.61055458e-01f,9.87629473e-01f,9.96082544e-01f,9.98760641e-01f,9.99608040e-01f,9.99876022e-01f,9.99960780e-01f,9.99987602e-01f,-7.48057544e-01f,-8.25371623e-01f,-9.67871487e-01f,4.30115849e-01f,-9.70958173e-01f,-5.99575676e-02f,6.08156204e-01f,8.69947195e-01f,9.58243906e-01f,9.86732066e-01f,9.95797932e-01f,9.98670578e-01f,9.99579549e-01f,9.99867022e-01f,9.99957979e-01f,9.99986708e-01f,1.54251456e-01f,-3.97251874e-01f,-9.98075247e-01f,5.83026946e-01f,-9.89992499e-01f,-1.15966164e-01f,5.82753658e-01f,8.61040652e-01f,9.55336511e-01f,9.85803485e-01f,9.95503366e-01f,9.98577297e-01f,9.99550045e-01f,9.99857724e-01f,9.99954998e-01f,9.99985754e-01f,9.14742351e-01f,1.53215483e-01f,-9.29300308e-01f,7.17549205e-01f,-9.99135137e-01f,-1.71608135e-01f,5.56768358e-01f,8.51861775e-01f,9.52333570e-01f,9.84843671e-01f,9.95198846e-01f,9.98480916e-01f,9.99519527e-01f,9.99848068e-01f,9.99951959e-01f,9.99984801e-01f,8.34223390e-01f,6.56495154e-01f,-7.68367112e-01f,8.29440355e-01f,-9.98294771e-01f,-2.26707578e-01f,5.30226350e-01f,8.42413545e-01f,9.49235439e-01f,9.83852804e-01f,9.94884372e-01f,9.98381376e-01f,9.99488056e-01f,9.99838114e-01f,9.99948800e-01f,9.99983788e-01f,-1.32767474e-02f,9.57586050e-01f,-5.31235278e-01f,9.15171385e-01f,-9.87479806e-01f,-2.81090319e-01f,5.03154159e-01f,8.32698941e-01f,9.46042359e-01f,9.82830763e-01f,9.94559944e-01f,9.98278618e-01f,9.99455571e-01f,9.99827802e-01f,9.99945521e-01f,9.99982774e-01f,-8.48570287e-01f,9.63757515e-01f,-2.41421118e-01f,9.72038329e-01f,-9.66798186e-01f,-3.34584385e-01f,4.75578904e-01f,8.22721004e-01f,9.42754686e-01f,9.81777668e-01f,9.94225562e-01f,9.98172760e-01f,9.99422073e-01f,9.99817252e-01f,9.99942183e-01f,9.99981701e-01f,-9.03692186e-01f,6.73110247e-01f,7.23346695e-02f,9.98247743e-01f,-9.36456680e-01f,-3.87020677e-01f,4.47528064e-01f,8.12482953e-01f,9.39372718e-01f,9.80693519e-01f,9.93881226e-01f,9.98063743e-01f,9.99387562e-01f,9.99806345e-01f,9.99938726e-01f,9.99980628e-01f,-1.27963692e-01f,1.75156534e-01f,3.78916174e-01f,9.92972851e-01f,-8.96758378e-01f,-4.38233554e-01f,4.19029742e-01f,8.01987886e-01f,9.35896814e-01f,9.79578316e-01f,9.93526995e-01f,9.97951567e-01f,9.99352098e-01f,9.99795079e-01f,9.99935210e-01f,9.99979496e-01f,7.65414059e-01f,-3.76742303e-01f,6.47921681e-01f,9.56380010e-01f,-8.48100007e-01f,-4.88060862e-01f,3.90112430e-01f,7.91239262e-01f,9.32327330e-01f,9.78432178e-01f,9.93162811e-01f,9.97836173e-01f,9.99315560e-01f,9.99783576e-01f,9.99931574e-01f,9.99978364e-01f,9.55073655e-01f,-8.12611222e-01f,8.52673113e-01f,8.89623463e-01f,-7.90967762e-01f,-5.36345184e-01f,3.60805035e-01f,7.80240417e-01f,9.28664625e-01f,9.77255106e-01f,9.92788672e-01f,9.97717679e-01f,9.99278069e-01f,9.99771714e-01f,9.99927819e-01f,9.99977171e-01f,2.66642928e-01f,-9.98210371e-01f,9.72865343e-01f,7.94808388e-01f,-7.25932240e-01f,-5.82933903e-01f,3.31136853e-01f,7.68994927e-01f,9.24909055e-01f,9.76047099e-01f,9.92404640e-01f,9.97596025e-01f,9.99239624e-01f,9.99759495e-01f,9.99923944e-01f,9.99975979e-01f,-6.66938066e-01f,-8.76379430e-01f,9.96578991e-01f,6.74925625e-01f,-6.53643608e-01f,-6.27679706e-01f,3.01137596e-01f,7.57506192e-01f,9.21060979e-01f,9.74808276e-01f,9.92010653e-01f,9.97471273e-01f,9.99200106e-01f,9.99747038e-01f,9.99920011e-01f,9.99974728e-01f,-9.87339258e-01f,-4.84639406e-01f,9.21462357e-01f,5.33756077e-01f,-5.74824035e-01f,-6.70441091e-01f,2.70837069e-01f,7.45777905e-01f,9.17120814e-01f,9.73538578e-01f,9.91606772e-01f,9.97343302e-01f,9.99159634e-01f,9.99734223e-01f,9.99915957e-01f,9.99973416e-01f,-3.99985313e-01f,5.63609414e-02f,7.54965365e-01f,3.75752151e-01f,-4.90260571e-01f,-7.11082935e-01f,2.40265876e-01f,7.33813822e-01f,9.13088918e-01f,9.72238123e-01f,9.91192937e-01f,9.97212172e-01f,9.99118149e-01f,9.99721110e-01f,9.99911785e-01f,9.99972105e-01f,5.55113316e-01f,5.80003142e-01f,5.13598442e-01f,2.05897167e-01f,-4.00799006e-01f,-7.49476731e-01f,2.09454417e-01f,7.21617639e-01f,9.08965766e-01f,9.70906913e-01f,9.90769207e-01f,9.97077882e-01f,9.99075651e-01f,9.99707639e-01f,9.99907553e-01f,9.99970794e-01f,9.99843299e-01f,9.25014675e-01f,2.21298173e-01f,2.95478199e-02f,-3.07332784e-01f,-7.85501122e-01f,1.78433523e-01f,7.09193349e-01f,9.04751658e-01f,9.69545007e-01f,9.90335584e-01f,9.96940494e-01f,9.99032140e-01f,9.99693930e-01f,9.99903202e-01f,9.99969363e-01f,5.25321960e-01f,9.85138178e-01f,-9.29481089e-02f,-1.47732988e-01f,-2.10795805e-01f,-8.19042206e-01f,1.47234216e-01f,6.96544766e-01f,9.00447130e-01f,9.68152404e-01f,9.89892066e-01f,9.96799886e-01f,9.98987675e-01f,9.99679863e-01f,9.99898732e-01f,9.99967992e-01f,-4.32177931e-01f,7.41858006e-01f,-3.97976756e-01f,-3.20354372e-01f,-1.12152621e-01f,-8.49993885e-01f,1.15887694e-01f,6.83675885e-01f,8.96052480e-01f,9.66729224e-01f,9.89438653e-01f,9.96656179e-01f,9.98942196e-01f,9.99665439e-01f,9.99894202e-01f,9.99966562e-01f,-9.92335498e-01f,2.70098448e-01f,-6.63538277e-01f,-4.82871950e-01f,-1.23883775e-02f,-8.78258407e-01f,8.44252855e-02f,6.70590878e-01f,8.91568303e-01f,9.65275466e-01f,9.88975346e-01f,9.96509314e-01f,9.98895705e-01f,9.99650776e-01f,9.99889553e-01f,9.99965072e-01f,-6.40144348e-01f,-2.84846604e-01f,-8.63296509e-01f,-6.30159974e-01f,8.74991715e-02f,-9.03746367e-01f,5.28784581e-02f,6.57293737e-01f,8.86994898e-01f,9.63791192e-01f,9.88502085e-01f,9.96359289e-01f,9.98848200e-01f,9.99635756e-01f,9.99884784e-01f,9.99963582e-01f,3.00592542e-01f,-7.52063990e-01f,-9.77442741e-01f,-7.57573068e-01f,1.86512470e-01f,-9.26377118e-01f,2.12787576e-02f,6.43788815e-01f,8.82332861e-01f,9.62276459e-01f,9.88018990e-01f,9.96206105e-01f,9.98799741e-01f,9.99620378e-01f,9.99879956e-01f,9.99962032e-01f,9.64965999e-01f,-9.87659097e-01f,-9.94656444e-01f,-8.61092687e-01f,2.83662200e-01f,-9.46079254e-01f,-1.03422189e-02f,6.30080283e-01f,8.77582550e-01f,9.60731268e-01f,9.87526000e-01f,9.96049762e-01f,9.98750269e-01f,9.99604762e-01f,9.99875009e-01f,9.99960482e-01f,7.42154181e-01f,-9.19073522e-01f,-9.13230121e-01f,-9.37454224e-01f,3.77977669e-01f,-9.62790370e-01f,-4.19528559e-02f,6.16172493e-01f,8.72744501e-01f,9.59155679e-01f,9.87023175e-01f,9.95890260e-01f,9.98699784e-01f,9.99588788e-01f,9.99869943e-01f,9.99958873e-01f,-1.62990779e-01f,-5.67430019e-01f,-7.41239965e-01f,-9.84248459e-01f,4.68516916e-01f,-9.76457715e-01f,-7.35215396e-02f,6.02069914e-01f,8.67819190e-01f,9.57549810e-01f,9.86510456e-01f,9.95727658e-01f,9.98648286e-01f,9.99572515e-01f,9.99864817e-01f,9.99957263e-01f,-9.18282807e-01f,-4.10281904e-02f,-4.95741814e-01f,-1.00000000e+00f,5.54374516e-01f,-9.87038016e-01f,-1.05016708e-01f,5.87776959e-01f,8.62807095e-01f,9.55913603e-01f,9.85987842e-01f,9.95561838e-01f,9.98595834e-01f,9.99555886e-01f,9.99859571e-01f,9.99955595e-01f,-8.29309821e-01f,4.98009592e-01f,-2.01079622e-01f,-9.84212041e-01f,6.34692967e-01f,-9.94497895e-01f,-1.36406869e-01f,5.73298037e-01f,8.57708693e-01f,9.54247177e-01f,9.85455394e-01f,9.95392919e-01f,9.98542368e-01f,9.99538958e-01f,9.99854207e-01f,9.99953866e-01f,2.21267566e-02f,8.83669317e-01f,1.13521777e-01f,-9.37382519e-01f,7.08669782e-01f,-9.98813629e-01f,-1.67660639e-01f,5.58637917e-01f,8.52524519e-01f,9.52550590e-01f,9.84913111e-01f,9.95220840e-01f,9.98487890e-01f,9.99521732e-01f,9.99848783e-01f,9.99952197e-01f,8.53220105e-01f,9.97174621e-01f,4.16867077e-01f,-8.60988438e-01f,7.75565803e-01f,-9.99971747e-01f,-1.98746875e-01f,5.43801069e-01f,8.47255111e-01f,9.50823903e-01f,9.84360933e-01f,9.95045662e-01f,9.98432398e-01f,9.99504209e-01f,9.99843180e-01f,9.99950409e-01f,8.99866819e-01f,8.03569078e-01f,6.78870201e-01f,-7.57439196e-01f,8.34712923e-01f,-9.97968495e-01f,-2.29634270e-01f,5.28792322e-01f,8.41901004e-01f,9.49067116e-01f,9.83798921e-01f,9.94867265e-01f,9.98375952e-01f,9.99486327e-01f,9.99837577e-01f,9.99948621e-01f,1.19180135e-01f,3.62476677e-01f,8.73550534e-01f,-6.30000710e-01f,8.85519624e-01f,-9.92810190e-01f,-2.60292053e-01f,5.13616323e-01f,8.36462677e-01f,9.47280347e-01f,9.83227074e-01f,9.94685769e-01f,9.98318493e-01f,9.99468148e-01f,9.99831796e-01f,9.99946833e-01f,-7.71080196e-01f,-1.90249100e-01f,9.81602073e-01f,-4.82692331e-01f,9.27478492e-01f,-9.84513164e-01f,-2.90689558e-01f,4.98277903e-01f,8.30940723e-01f,9.45463598e-01f,9.82645452e-01f,9.94501114e-01f,9.98260021e-01f,9.99449670e-01f,9.99825954e-01f,9.99944985e-01f,-9.52412963e-01f,-6.84381902e-01f,9.92308319e-01f,-3.20159167e-01f,9.60170269e-01f,-9.73103702e-01f,-3.20796400e-01f,4.82782036e-01f,8.25335622e-01f,9.43616986e-01f,9.82053936e-01f,9.94313300e-01f,9.98200536e-01f,9.99430835e-01f,9.99819994e-01f,9.99943078e-01f,-2.58101642e-01f,-9.67739642e-01f,9.04607594e-01f,-1.47529200e-01f,9.83268440e-01f,-9.58617806e-01f,-3.50582451e-01f,4.67133403e-01f,8.19648027e-01f,9.41740453e-01f,9.81452644e-01f,9.94122326e-01f,9.98140097e-01f,9.99411702e-01f,9.99813974e-01f,9.99941170e-01f,6.73507154e-01f,-9.53050017e-01f,7.27198064e-01f,2.97537707e-02f,9.96542096e-01f,-9.41101313e-01f,-3.80017966e-01f,4.51337039e-01f,8.13878477e-01f,9.39834237e-01f,9.80841517e-01f,9.93928254e-01f,9.98078644e-01f,9.99392271e-01f,9.99807835e-01f,9.99939203e-01f,9.85896587e-01f,-6.44837022e-01f,4.77671444e-01f,2.06098333e-01f,9.99858618e-01f,-9.20609534e-01f,-4.09073502e-01f,4.35397953e-01f,8.08027506e-01f,9.37898219e-01f,9.80220556e-01f,9.93731022e-01f,9.98016179e-01f,9.99372482e-01f,9.99801576e-01f,9.99937236e-01f};
__device__ __attribute__((aligned(16))) const float ROPE_SIN[1024] = {0.00000000e+00f,0.00000000e+00f,0.00000000e+00f,0.00000000e+00f,0.00000000e+00f,0.00000000e+00f,0.00000000e+00f,0.00000000e+00f,0.00000000e+00f,0.00000000e+00f,0.00000000e+00f,0.00000000e+00f,0.00000000e+00f,0.00000000e+00f,0.00000000e+00f,0.00000000e+00f,8.41470957e-01f,5.33168435e-01f,3.10983598e-01f,1.76892191e-01f,9.98334214e-02f,5.62044978e-02f,3.16175036e-02f,1.77818574e-02f,9.99983307e-03f,5.62338345e-03f,3.16227227e-03f,1.77827850e-03f,9.99999931e-04f,5.62341243e-04f,3.16227757e-04f,1.77827940e-04f,9.09297407e-01f,9.02130723e-01f,5.91127098e-01f,3.48205268e-01f,1.98669329e-01f,1.12231314e-01f,6.32033944e-02f,3.55580896e-02f,1.99986659e-02f,1.12465890e-02f,6.32451288e-03f,3.55655141e-03f,1.99999870e-03f,1.12468237e-03f,6.32455456e-04f,3.55655880e-04f,1.41120002e-01f,9.93253171e-01f,8.12648892e-01f,5.08536100e-01f,2.95520216e-01f,1.67903304e-01f,9.47260857e-02f,5.33230826e-02f,2.99954992e-02f,1.68694388e-02f,9.48669016e-03f,5.33481315e-03f,2.99999560e-03f,1.68702309e-03f,9.48683126e-04f,5.33483806e-04f,-7.56802499e-01f,7.78471708e-01f,9.53580737e-01f,6.52827978e-01f,3.89418334e-01f,2.23044485e-01f,1.26154065e-01f,7.10712075e-02f,3.99893336e-02f,2.24917568e-02f,1.26487734e-02f,7.11305765e-03f,3.99998948e-03f,2.24936334e-03f,1.26491068e-03f,7.11311703e-04f,-9.58924294e-01f,3.23935270e-01f,9.99946535e-01f,7.76529968e-01f,4.79425550e-01f,2.77480543e-01f,1.57455876e-01f,8.87968615e-02f,4.99791652e-02f,2.81133614e-02f,1.58107281e-02f,8.89127981e-03f,4.99997940e-03f,2.81170290e-03f,1.58113812e-03f,8.89139599e-04f,-2.79415488e-01f,-2.30367512e-01f,9.47148204e-01f,8.75740528e-01f,5.64642489e-01f,3.31039310e-01f,1.88600272e-01f,1.06494442e-01f,5.99640049e-02f,3.37340795e-02f,1.89725272e-02f,1.06694745e-02f,5.99996420e-03f,3.37404152e-03f,1.89736532e-03f,1.06696738e-03f,6.56986594e-01f,-7.13721275e-01f,8.00421596e-01f,9.47330713e-01f,6.44217670e-01f,3.83551568e-01f,2.19556093e-01f,1.24158338e-01f,6.99428469e-02f,3.93537246e-02f,2.21341345e-02f,1.24476347e-02f,6.99994294e-03f,3.93637875e-03f,2.21359241e-03f,1.24479528e-03f,9.89358246e-01f,-9.77261782e-01f,5.74317753e-01f,9.89042461e-01f,7.17356086e-01f,4.34851229e-01f,2.50292331e-01f,1.41782969e-01f,7.99146891e-02f,4.49721329e-02f,2.52955221e-02f,1.42257558e-02f,7.99991470e-03f,4.49871505e-03f,2.52981926e-03f,1.42262306e-03f,4.12118495e-01f,-9.39823508e-01f,2.91259229e-01f,9.99560297e-01f,7.83326924e-01f,4.84776139e-01f,2.80778319e-01f,1.59362778e-01f,8.98785442e-02f,5.05891182e-02f,2.84566563e-02f,1.60038304e-02f,8.99987947e-03f,5.06105041e-03f,2.84604589e-03f,1.60045072e-03f,-5.44021130e-01f,-6.12936914e-01f,-2.06835698e-02f,9.78552461e-01f,8.41470957e-01f,5.33168435e-01f,3.10983568e-01f,1.76892191e-01f,9.98334140e-02f,5.62044978e-02f,3.16175036e-02f,1.77818574e-02f,9.99983400e-03f,5.62338345e-03f,3.16227227e-03f,1.77827850e-03f,-9.99990225e-01f,-9.72764567e-02f,-3.30574960e-01f,9.26681578e-01f,8.91207397e-01f,5.79875171e-01f,3.40877861e-01f,1.94365650e-01f,1.09778300e-01f,6.18181042e-02f,3.47780399e-02f,1.95598267e-02f,1.09997792e-02f,6.18571462e-03f,3.47849843e-03f,1.95610616e-03f,-5.36572933e-01f,4.48342979e-01f,-6.07683420e-01f,8.45583618e-01f,9.32039082e-01f,6.24748647e-01f,3.70431304e-01f,2.11777672e-01f,1.19712204e-01f,6.74297586e-02f,3.79382223e-02f,2.13377345e-02f,1.19997123e-02f,6.74804440e-03f,3.79472389e-03f,2.13393359e-03f,4.20167029e-01f,8.55880976e-01f,-8.24528456e-01f,7.37816215e-01f,9.63558197e-01f,6.67647004e-01f,3.99614304e-01f,2.29122713e-01f,1.29634142e-01f,7.30392784e-02f,4.10980321e-02f,2.31155735e-02f,1.29996343e-02f,7.31037185e-03f,4.11094911e-03f,2.31176103e-03f,9.90607381e-01f,9.99823332e-01f,-9.59605396e-01f,6.06778562e-01f,9.85449731e-01f,7.08434701e-01f,4.28397775e-01f,2.46395305e-01f,1.39543116e-01f,7.86464810e-02f,4.42574248e-02f,2.48933397e-02f,1.39995432e-02f,7.87269697e-03f,4.42717411e-03f,2.48958869e-03f,6.50287867e-01f,8.35838437e-01f,-9.99518692e-01f,4.56603259e-01f,9.97494996e-01f,7.46982634e-01f,4.56752867e-01f,2.63589978e-01f,1.49438128e-01f,8.42512026e-02f,4.74163815e-02f,2.66710296e-02f,1.49994381e-02f,8.43502022e-03f,4.74339863e-03f,2.66741589e-03f,-2.87903309e-01f,4.14430231e-01f,-9.40310359e-01f,2.92027086e-01f,9.99573588e-01f,7.83169091e-01f,4.84651238e-01f,2.80701309e-01f,1.59318209e-01f,8.98532644e-02f,5.05748577e-02f,2.84486320e-02f,1.59993190e-02f,8.99733976e-03f,5.05962269e-03f,2.84524332e-03f,-9.61397469e-01f,-1.34615138e-01f,-7.87851870e-01f,1.18240520e-01f,9.91664827e-01f,8.16879570e-01f,5.12064993e-01f,2.97723860e-01f,1.69182345e-01f,9.54524800e-02f,5.37328273e-02f,3.02261449e-02f,1.69991814e-02f,9.55965649e-03f,5.37584582e-03f,3.02307028e-03f,-7.50987232e-01f,-6.42200708e-01f,-5.57262897e-01f,-5.92755191e-02f,9.73847628e-01f,8.48007560e-01f,5.38966715e-01f,3.14652264e-01f,1.79029569e-01f,1.01048686e-01f,5.68902642e-02f,3.20035629e-02f,1.79990288e-02f,1.01219704e-02f,5.69206895e-03f,3.20089748e-03f,1.49877205e-01f,-9.52000856e-01f,-2.71410108e-01f,-2.34921798e-01f,9.46300089e-01f,8.76454532e-01f,5.65329552e-01f,3.31481189e-01f,1.88858896e-01f,1.06641680e-01f,6.00471310e-02f,3.37808803e-02f,1.89988576e-02f,1.06842816e-02f,6.00829115e-03f,3.37872445e-03f,9.12945271e-01f,-9.68601942e-01f,4.13582884e-02f,-4.03158993e-01f,9.09297407e-01f,9.02130723e-01f,5.91127038e-01f,3.48205268e-01f,1.98669314e-01f,1.12231314e-01f,6.32033944e-02f,3.55580896e-02f,1.99986678e-02f,1.12465890e-02f,6.32451288e-03f,3.55655141e-03f,8.36655617e-01f,-6.86891198e-01f,3.50024760e-01f,-5.58680534e-01f,8.63209307e-01f,9.24954832e-01f,6.16333544e-01f,3.64819258e-01f,2.08459899e-01f,1.17817394e-01f,6.63590282e-02f,3.73351872e-02f,2.09984574e-02f,1.18088927e-02f,6.64073415e-03f,3.73437814e-03f,-8.85130931e-03f,-1.93630233e-01f,6.23979926e-01f,-6.96581721e-01f,8.08496356e-01f,9.44854796e-01f,6.40923738e-01f,3.81317884e-01f,2.18229622e-01f,1.23399742e-01f,6.95140064e-02f,3.91121693e-02f,2.19982266e-02f,1.23711927e-02f,6.95695449e-03f,3.91220488e-03f,-8.46220434e-01f,3.59264523e-01f,8.36055279e-01f,-8.12512875e-01f,7.45705247e-01f,9.61767614e-01f,6.64873064e-01f,3.97695929e-01f,2.27977514e-01f,1.28978193e-01f,7.26682767e-02f,4.08890247e-02f,2.29979735e-02f,1.29334899e-02f,7.27317436e-03f,4.09003161e-03f,-9.05578375e-01f,8.01513135e-01f,9.65219259e-01f,-9.02817786e-01f,6.75463140e-01f,9.75639880e-01f,6.88157499e-01f,4.13948208e-01f,2.37702623e-01f,1.34552568e-01f,7.58218244e-02f,4.26657498e-02f,2.39976961e-02f,1.34957815e-02f,7.58939330e-03f,4.26785741e-03f,-1.32351756e-01f,9.96909976e-01f,9.98663187e-01f,-9.64648306e-01f,5.98472118e-01f,9.86427724e-01f,7.10753918e-01f,4.30069596e-01f,2.47403964e-01f,1.40122697e-01f,7.89746121e-02f,4.44423407e-02f,2.49973964e-02f,1.40580693e-02f,7.90561177e-03f,4.44568414e-03f,7.62558460e-01f,8.85276794e-01f,9.33070183e-01f,-9.96054351e-01f,5.15501261e-01f,9.94096994e-01f,7.32639611e-01f,4.46054995e-01f,2.57080555e-01f,1.45688385e-01f,8.21266174e-02f,4.62187938e-02f,2.59970706e-02f,1.46203535e-02f,8.22182931e-03f,4.62350994e-03f,9.56375957e-01f,5.00994205e-01f,7.74945021e-01f,-9.96045172e-01f,4.27379847e-01f,9.98623490e-01f,7.53792703e-01f,4.61899310e-01f,2.66731411e-01f,1.51249468e-01f,8.52777958e-02f,4.79951017e-02f,2.69967206e-02f,1.51826320e-02f,8.53804592e-03f,4.80133574e-03f,2.70905793e-01f,-3.75856608e-02f,5.39968967e-01f,-9.64621305e-01f,3.34988207e-01f,9.99992907e-01f,7.74192095e-01f,4.77597594e-01f,2.76355654e-01f,1.56805754e-01f,8.84281173e-02f,4.97712530e-02f,2.79963426e-02f,1.57449059e-02f,8.85426160e-03f,4.97916201e-03f,-6.63633883e-01f,-5.64589798e-01f,2.51445323e-01f,-9.02773678e-01f,2.39249229e-01f,9.98200953e-01f,7.93817401e-01f,4.93144840e-01f,2.85952210e-01f,1.62357092e-01f,9.15775672e-02f,5.15472479e-02f,2.89959367e-02f,1.63071752e-02f,9.17047635e-03f,5.15698735e-03f,-9.88031626e-01f,-9.17709649e-01f,-6.20148405e-02f,-8.12452853e-01f,1.41120002e-01f,9.93253171e-01f,8.12648892e-01f,5.08536100e-01f,2.95520186e-01f,1.67903304e-01f,9.47260931e-02f,5.33230826e-02f,2.99955010e-02f,1.68694388e-02f,9.48669016e-03f,5.33481315e-03f,-4.04037654e-01f,-9.88192797e-01f,-3.69325012e-01f,-6.96507812e-01f,4.15805206e-02f,9.85165298e-01f,8.30667794e-01f,5.23766637e-01f,3.05058628e-01f,1.73444211e-01f,9.78736654e-02f,5.50987460e-02f,3.09950355e-02f,1.74316969e-02f,9.80290305e-03f,5.51263802e-03f,5.51426709e-01f,-7.54330218e-01f,-6.40009403e-01f,-5.58595300e-01f,-5.83741926e-02f,9.73962843e-01f,8.47856104e-01f,5.38831532e-01f,3.14566553e-01f,1.78979620e-01f,1.01020269e-01f,5.68742342e-02f,3.19945402e-02f,1.79939512e-02f,1.01191159e-02f,5.69046335e-03f,9.99911845e-01f,-2.88147390e-01f,-8.47224355e-01f,-4.03064936e-01f,-1.57745644e-01f,9.59681332e-01f,8.64196658e-01f,5.53726017e-01f,3.24043006e-01f,1.84509367e-01f,1.04165860e-01f,5.86495437e-02f,3.29940096e-02f,1.85561981e-02f,1.04353270e-02f,5.86828869e-03f,5.29082716e-01f,2.66779721e-01f,-9.70420420e-01f,-2.34822124e-01f,-2.55541205e-01f,9.42365825e-01f,8.79673064e-01f,5.68445385e-01f,3.33487093e-01f,1.90033287e-01f,1.07310407e-01f,6.04246669e-02f,3.39934528e-02f,1.91184394e-02f,1.07515370e-02f,6.04611309e-03f,-4.28182662e-01f,7.39542127e-01f,-9.97380435e-01f,-5.91726787e-02f,-3.50783229e-01f,9.22071040e-01f,8.94269884e-01f,5.82984984e-01f,3.42897803e-01f,1.95551202e-01f,1.10453881e-01f,6.21996038e-02f,3.49928550e-02f,1.96806751e-02f,1.10677453e-02f,6.22393796e-03f,-9.91778851e-01f,9.84540582e-01f,-9.25431013e-01f,1.18342586e-01f,-4.42520559e-01f,8.98861170e-01f,9.07972515e-01f,5.97340286e-01f,3.52274209e-01f,2.01062918e-01f,1.13596253e-01f,6.39743358e-02f,3.59922275e-02f,2.02429052e-02f,1.13839535e-02f,6.40176190e-03f,-6.43538117e-01f,9.26318109e-01f,-7.61706948e-01f,2.92125374e-01f,-5.29836178e-01f,8.72809589e-01f,9.20767248e-01f,6.11506701e-01f,3.61615449e-01f,2.06568271e-01f,1.16737492e-01f,6.57488778e-02f,3.69915590e-02f,2.08051261e-02f,1.17001599e-02f,6.57958630e-03f,2.96368569e-01f,5.82806170e-01f,-5.22444785e-01f,4.56694692e-01f,-6.11857831e-01f,8.43998730e-01f,9.32641268e-01f,6.25479698e-01f,3.70920479e-01f,2.12067112e-01f,1.19877554e-01f,6.75232038e-02f,3.79908569e-02f,2.13673431e-02f,1.20163653e-02f,6.75741071e-03f,9.63795364e-01f,5.98003156e-02f,-2.31372014e-01f,6.06860459e-01f,-6.87766254e-01f,8.12519610e-01f,9.43582714e-01f,6.39254928e-01f,3.80188406e-01f,2.17559248e-01f,1.23016424e-01f,6.92973137e-02f,3.89901139e-02f,2.19295528e-02f,1.23325698e-02f,6.93523418e-03f,7.45113134e-01f,-4.81621295e-01f,8.26458037e-02f,7.37885714e-01f,-7.56802499e-01f,7.78471708e-01f,9.53580678e-01f,6.52827978e-01f,3.89418334e-01f,2.23044485e-01f,1.26154065e-01f,7.10712075e-02f,3.99893373e-02f,2.24917568e-02f,1.26487734e-02f,7.11305765e-03f,-1.58622667e-01f,-8.74714017e-01f,3.88467699e-01f,8.45638454e-01f,-8.18277061e-01f,7.41962790e-01f,9.62625206e-01f,6.66194677e-01f,3.98609310e-01f,2.28522688e-01f,1.29290432e-01f,7.28448778e-02f,4.09885161e-02f,2.30539497e-02f,1.29649751e-02f,7.29088066e-03f,-9.16521549e-01f,-9.98410463e-01f,6.55764699e-01f,9.26720202e-01f,-8.71575892e-01f,7.03108132e-01f,9.70707119e-01f,6.79350674e-01f,4.07760441e-01f,2.33993664e-01f,1.32425532e-01f,7.46183172e-02f,4.19876575e-02f,2.36161388e-02f,1.32811759e-02f,7.46870413e-03f,-8.31774771e-01f,-8.14614236e-01f,8.58030677e-01f,9.78573620e-01f,-9.16166008e-01f,6.62030637e-01f,9.77818429e-01f,6.92291796e-01f,4.16870773e-01f,2.39457220e-01f,1.35559291e-01f,7.63915181e-02f,4.29867506e-02f,2.41783205e-02f,1.35973748e-02f,7.64652714e-03f,1.77019257e-02f,-3.79931390e-01f,9.75206196e-01f,9.99563396e-01f,-9.51602101e-01f,6.18860185e-01f,9.83951986e-01f,7.05014050e-01f,4.25939471e-01f,2.44913206e-01f,1.38691694e-01f,7.81644881e-02f,4.39858064e-02f,2.47404929e-02f,1.39135728e-02f,7.82434922e-03f,8.50903511e-01f,1.71763569e-01f,9.95670974e-01f,9.89027262e-01f,-9.77530122e-01f,5.73733270e-01f,9.89101648e-01f,7.17513323e-01f,4.34965521e-01f,2.50361472e-01f,1.41822711e-01f,7.99371973e-02f,4.49848175e-02f,2.53026579e-02f,1.42297689e-02f,8.00217129e-03f,9.01788354e-01f,6.70557022e-01f,9.17395473e-01f,9.47297752e-01f,-9.93690968e-01f,5.26792526e-01f,9.93262351e-01f,7.29785740e-01f,4.43948090e-01f,2.55801797e-01f,1.44952312e-01f,8.17096606e-02f,4.59837839e-02f,2.58648153e-02f,1.45459641e-02f,8.17999430e-03f,1.23573124e-01f,9.62832689e-01f,7.48142362e-01f,8.75690997e-01f,-9.99923289e-01f,4.78186339e-01f,9.96429801e-01f,7.41827428e-01f,4.52886283e-01f,2.61234075e-01f,1.48080453e-01f,8.34818557e-02f,4.69827019e-02f,2.64269635e-02f,1.48621574e-02f,8.35781638e-03f,-7.68254638e-01f,9.58573103e-01f,5.04697084e-01f,7.76465356e-01f,-9.96164620e-01f,4.28068399e-01f,9.98600960e-01f,7.53634512e-01f,4.61779177e-01f,2.66658038e-01f,1.51207119e-01f,8.52537975e-02f,4.79815714e-02f,2.69891042e-02f,1.51783489e-02f,8.53563752e-03f,-9.53752637e-01f,6.59090102e-01f,2.11200655e-01f,6.52750373e-01f,-9.82452571e-01f,3.76597136e-01f,9.99773562e-01f,7.65203178e-01f,4.70625877e-01f,2.72073567e-01f,1.54332280e-01f,8.70254710e-02f,4.89803962e-02f,2.75512375e-02f,1.54945394e-02f,8.71345960e-03f,-2.62374848e-01f,1.56619072e-01f,-1.03240460e-01f,5.08447945e-01f,-9.58924294e-01f,3.23935270e-01f,9.99946535e-01f,7.76529968e-01f,4.79425550e-01f,2.77480543e-01f,1.57455891e-01f,8.87968615e-02f,4.99791689e-02f,2.81133596e-02f,1.58107281e-02f,8.89127981e-03f,6.70229197e-01f,-3.94086063e-01f,-4.07444149e-01f,3.48108500e-01f,-9.25814748e-01f,2.70249337e-01f,9.99119580e-01f,7.87611187e-01f,4.88177240e-01f,2.82878697e-01f,1.60577938e-01f,9.05679762e-02f,5.09778969e-02f,2.86754742e-02f,1.61269177e-02f,9.06910095e-03f,9.86627579e-01f,-8.23421597e-01f,-6.71240151e-01f,1.76790684e-01f,-8.83454502e-01f,2.15709001e-01f,9.97293651e-01f,7.98443377e-01f,4.96880114e-01f,2.88267940e-01f,1.63698375e-01f,9.23388004e-02f,5.19765690e-02f,2.92375814e-02f,1.64431017e-02f,9.24692024e-03f,3.95925164e-01f,-9.99157965e-01f,-8.68469954e-01f,-1.03020677e-04f,-8.32267344e-01f,1.60486728e-01f,9.94470477e-01f,8.09023023e-01f,5.05533338e-01f,2.93648034e-01f,1.66817173e-01f,9.41093415e-02f,5.29751927e-02f,2.97996756e-02f,1.67592876e-02f,9.42474138e-03f,-5.58789074e-01f,-8.67171526e-01f,-9.79574919e-01f,-1.76993474e-01f,-7.72764444e-01f,1.04756832e-01f,9.90652919e-01f,8.19346905e-01f,5.14135957e-01f,2.99018890e-01f,1.69934288e-01f,9.58795771e-02f,5.39737605e-02f,3.03617641e-02f,1.70754679e-02f,9.60256159e-03f,-9.99755144e-01f,-4.68111664e-01f,-9.93535519e-01f,-3.48301649e-01f,-7.05540299e-01f,4.86960001e-02f,9.85844791e-01f,8.29411685e-01f,5.22687256e-01f,3.04380238e-01f,1.73049718e-01f,9.76495072e-02f,5.49722798e-02f,3.09238415e-02f,1.73916500e-02f,9.78038087e-03f,-5.21551013e-01f,7.51182064e-02f,-9.08967435e-01f,-5.08624554e-01f,-6.31266713e-01f,-7.51878507e-03f,9.80050862e-01f,8.39214146e-01f,5.31186223e-01f,3.09731960e-01f,1.76163420e-01f,9.94191393e-02f,5.59707358e-02f,3.14859077e-02f,1.77078284e-02f,9.95820016e-03f,4.36164767e-01f,5.95211506e-01f,-7.34258294e-01f,-6.52905703e-01f,-5.50685287e-01f,-6.37097955e-02f,9.73276973e-01f,8.48751247e-01f,5.39632022e-01f,3.15073937e-01f,1.79275364e-01f,1.01188451e-01f,5.69691435e-02f,3.20479684e-02f,1.80240069e-02f,1.01360194e-02f,9.92872655e-01f,9.31992829e-01f,-4.86733496e-01f,-7.76594579e-01f,-4.64602023e-01f,-1.19699396e-01f,9.65529919e-01f,8.58020008e-01f,5.48023939e-01f,3.20405900e-01f,1.82385504e-01f,1.02957435e-01f,5.79674877e-02f,3.26100141e-02f,1.83401816e-02f,1.03138378e-02f,6.36738002e-01f,9.81735826e-01f,-1.90938011e-01f,-8.75790000e-01f,-3.73876572e-01f,-1.75310582e-01f,9.56817448e-01f,8.67017388e-01f,5.56361020e-01f,3.25727791e-01f,1.85493827e-01f,1.04726106e-01f,5.89657798e-02f,3.31720486e-02f,1.86563563e-02f,1.04916561e-02f,-3.04810613e-01f,7.29123712e-01f,1.23790950e-01f,-9.47363734e-01f,-2.79415488e-01f,-2.30367512e-01f,9.47148204e-01f,8.75740528e-01f,5.64642429e-01f,3.31039310e-01f,1.88600287e-01f,1.06494442e-01f,5.99640086e-02f,3.37340795e-02f,1.89725272e-02f,1.06694745e-02f,-9.66117799e-01f,2.51952261e-01f,4.26245421e-01f,-9.89057720e-01f,-1.82162598e-01f,-2.84696162e-01f,9.36531842e-01f,8.84186864e-01f,5.72867453e-01f,3.36340427e-01f,1.91704854e-01f,1.08262435e-01f,6.09621815e-02f,3.42960916e-02f,1.92886982e-02f,1.08472919e-02f,-7.39180684e-01f,-3.02812874e-01f,6.86427653e-01f,-9.99557257e-01f,-8.30891207e-02f,-3.38124752e-01f,9.24979091e-01f,8.92353535e-01f,5.81035137e-01f,3.41630876e-01f,1.94807529e-01f,1.10030092e-01f,6.19602874e-02f,3.48580964e-02f,1.96048655e-02f,1.10251084e-02f,1.67355701e-01f,-7.64320076e-01f,8.78538549e-01f,-9.78531301e-01f,1.68140903e-02f,-3.90484393e-01f,9.12501454e-01f,9.00238097e-01f,5.89144766e-01f,3.46910536e-01f,1.97908238e-01f,1.11797392e-01f,6.29583374e-02f,3.54200937e-02f,1.99210308e-02f,1.12029258e-02f};


constexpr int D = 1024, NB = 16, T = 4096, CL = 256;
constexpr int NLAT = NB * T, NCTX = NB * CL, NR = NLAT + NCTX;
constexpr int DFF = 2688, DFF2 = 5376, AB_IN = 1280, C_IN = 1536;
constexpr float EPS = 1e-6f;
constexpr float LOG2E = 1.4426950408889634f;
constexpr float QSCALE = 0.125f * LOG2E;
constexpr int RING_BYTES = 131072, EX_BYTES = 16384, CW_BYTES = 8192, LDS_BYTES = RING_BYTES + EX_BYTES + CW_BYTES;
constexpr int NTHR = 512, NWAVE = 8;
constexpr int NPHASE = 30;

struct Params {
    const float *x, *c, *ctx, *c_ctx, *ada_w, *ada_b, *mix_pre_g, *mix_post_g, *ffn_pre_g, *ffn_post_g;
    const float *ab_w_in, *ab_w_out, *pool_w, *pool_scale, *sink_logit, *c_w_qkv, *c_w_out, *c_q_g, *c_k_g;
    const float *ffn_w_up, *ffn_conv_w, *ffn_conv_b, *ffn_w_down;
    float* out;
    bf16_t* xres;
    bf16_t* H;
    bf16_t* Y;
    bf16_t* PG;
    float* ada;
    unsigned* bar;
    bf16_t* wt_in_b;
    bf16_t* wt_out_b;
    bf16_t* wt_up_b;
    bf16_t* wt_down_b;
    bf16_t* wt_pool_b;
    DI bf16_t* wt_in(int l) const { return wt_in_b + (size_t)l * C_IN * D; }
    DI bf16_t* wt_out(int l) const { return wt_out_b + (size_t)l * D * D; }
    DI bf16_t* wt_up(int l) const { return wt_up_b + (size_t)l * DFF2 * D; }
    DI bf16_t* wt_down(int l) const { return wt_down_b + (size_t)l * D * DFF; }
    DI bf16_t* wt_pool(int li) const { return wt_pool_b + (size_t)li * 4 * 128 * 128; }
    int ph_lo, ph_hi;
};

DI int get_tid() { int t = threadIdx.x; asm volatile("" : "+v"(t)); return t; }
DI float shx(float v, int k, int lane) { return __builtin_bit_cast(float, __builtin_amdgcn_ds_bpermute((lane ^ k) << 2, __builtin_bit_cast(int, v))); }
DI unsigned pack2(float lo, float hi) { f32x2 v = {lo, hi}; bf16x2_t b = __builtin_convertvector(v, bf16x2_t); return __builtin_bit_cast(unsigned, b); }
DI float bf2f(unsigned v16) { return __uint_as_float(v16 << 16); }
DI int crow(int i, int h) { return (i & 3) + 8 * (i >> 2) + 4 * h; }
#define MFMA32(a, b, c) __builtin_amdgcn_mfma_f32_32x32x16_bf16((a), (b), (c), 0, 0, 0)
DI float opaque0() { float z; asm volatile("v_mov_b32 %0, 0" : "=v"(z)); return z; }
DI float fast_exp2(float x) { return __builtin_amdgcn_exp2f(x); }
DI float sigmoidf_(float x) { return 1.0f / (1.0f + __expf(-x)); }
DI float gelu_tanh(float x) {
    const float u = x * x, t = x * (u * (-2.0f * 0.7978845608028654f * 0.044715f * LOG2E) + (-2.0f * 0.7978845608028654f * LOG2E));
    return x * __builtin_amdgcn_rcpf(1.0f + fast_exp2(t)); }


constexpr int BM = 256, BK = 64, HALF = 128, HTB = HALF * BK * 2, NXCD = 8, WGM = 8;
DI int lds_byte(int r, int c) { const int st = (r >> 4) * 2 + (c >> 5), rr = r & 15, cc = c & 31, ob = rr * 64 + cc * 2; return st * 1024 + (ob ^ (((ob >> 9) & 1) << 5)); }
DI void stage_rc(int b, int& R, int& C) { const int st = b / 1024, sb = b % 1024, swz = sb ^ (((sb >> 9) & 1) << 5); R = (st >> 1) * 16 + swz / 64; C = (st & 1) * 32 + (swz % 64) / 2; }
DI int perm32(int rho) { const int n = rho >> 4, i = rho & 15; return 8 * (i >> 2) + 4 * n + (i & 3); }
struct Unit { int pm, pn, seq; };
struct Gemm { const bf16_t* A; const bf16_t* Bt; int K; size_t a_tstep; };
struct StaticOrder {
    int nM, nN, nwg, G, c;
    DI void init(int nM_, int nN_, int G_, int c_) { nM = nM_; nN = nN_; nwg = nM * nN; G = G_; c = c_; }
    DI bool next(int i, Unit& u) const {
        const long L = (long)i * G + c; if (L >= nwg) return false;
        int wgid = (int)L; { const int q = nwg / NXCD, r = nwg % NXCD, xcd = wgid % NXCD, off = wgid / NXCD; wgid = (xcd < r ? xcd * (q + 1) : r * (q + 1) + (xcd - r) * q) + off; }
        const int nig = WGM * nN, gid = wgid / nig, fm = gid * WGM, gsz = (nM - fm) < WGM ? (nM - fm) : WGM;
        u.pm = fm + ((wgid % nig) % gsz); u.pn = (wgid % nig) / gsz; u.seq = i; return true;
    }
    DI void a_ready(const Unit&) const {}
    DI void done(const Unit&) const {}
};
template <class Epi, class Sched, bool ALIGN_EPI = false, bool SP2 = false>
__device__ __forceinline__ void gemm_phase(LAS unsigned char* lds, const Gemm g, const Sched& S, const Epi& E) {
    const int tid = get_tid(), wid = __builtin_amdgcn_readfirstlane(tid >> 6), lane = tid & 63, wr = wid >> 2, wc = wid & 3, fr = lane & 15, fq = lane >> 4;
    const int K = g.K, nt = K / BK;
    unsigned voffA[2], voffB[2];
#pragma unroll
    for (int i = 0; i < 2; ++i) { int R, C; stage_rc(tid * 16 + i * 8192, R, C); const int Rb = Epi::PERM ? ((R & ~31) + perm32(R & 31)) : R;
        voffA[i] = (unsigned)(R * K + C) * 2u; voffB[i] = (unsigned)(Rb * K + C) * 2u; }
    const size_t kstep = (size_t)(BK * 2);
    const size_t hstep = (size_t)HALF * K * 2;
    const size_t tstep = 2 * hstep;
    const unsigned ldsw = (unsigned)wid * 1024u;
    const int aoff = lds_byte(wr * 64 + fr, fq * 8), boff = lds_byte(wc * 32 + fr, fq * 8);
#define PG8_SA(b, h) (((b) * 2 + (h)) * HTB)
#define PG8_SB(b, h) ((4 + (b) * 2 + (h)) * HTB)
#define PG8_STAGE(bufoff, gbase, voff) do { _Pragma("unroll") for (int _i = 0; _i < 2; ++_i) \
        __builtin_amdgcn_global_load_lds((const unsigned*)((const char*)(gbase) + (voff)[_i]), (LAS unsigned*)(lds + (bufoff) + ldsw + _i * 8192), 16, 0, 0); } while (0)
#define PG8_LDA(dst, b, h) do { _Pragma("unroll") for (int m = 0; m < 4; ++m) _Pragma("unroll") for (int k = 0; k < 2; ++k) dst[m][k] = *(const LAS bf16x8*)(lds + PG8_SA(b, h) + aoff + m * 2048 + k * 1024); } while (0)
#define PG8_LDB(dst, b, h) do { _Pragma("unroll") for (int n = 0; n < 2; ++n) _Pragma("unroll") for (int k = 0; k < 2; ++k) dst[n][k] = *(const LAS bf16x8*)(lds + PG8_SB(b, h) + boff + n * 2048 + k * 1024); } while (0)
#define PG8_MMA(ai, bj, At, Bt) do { __builtin_amdgcn_s_setprio(1); _Pragma("unroll") for (int m = 0; m < 4; ++m) _Pragma("unroll") for (int n = 0; n < 2; ++n) _Pragma("unroll") for (int k = 0; k < 2; ++k) \
        acc[ai][bj][m][n] = __builtin_amdgcn_mfma_f32_16x16x32_bf16(Bt[n][k], At[m][k], acc[ai][bj][m][n], 0, 0, 0); __builtin_amdgcn_s_setprio(0); } while (0)
#define PG8_WAIT_V(n) asm volatile("s_waitcnt vmcnt(" #n ")" ::: "memory")
#define PG8_WAIT_L(n) asm volatile("s_waitcnt lgkmcnt(" #n ")" ::: "memory")
#define PG8_BAR __builtin_amdgcn_s_barrier()
#define PG8_SCHED __builtin_amdgcn_sched_barrier(0)
    Unit cur, nxt; int ui = 0;
    if (!S.next(0, cur)) return;
    f32x4 acc[2][2][4][2];
#pragma unroll
    for (int a = 0; a < 2; ++a)
#pragma unroll
        for (int b = 0; b < 2; ++b)
#pragma unroll
            for (int m = 0; m < 4; ++m)
#pragma unroll
                for (int n = 0; n < 2; ++n) acc[a][b][m][n] = (f32x4){0.f, 0.f, 0.f, 0.f};
    bf16x8 At[4][2], B0[2][2], B1[2][2];
    const char* cA = (const char*)g.A + (size_t)cur.pm * g.a_tstep; const char* cB = (const char*)g.Bt + (size_t)cur.pn * tstep;
    S.a_ready(cur);
    if constexpr (SP2) {
        PG8_STAGE(PG8_SB(0, 0), cB, voffB); PG8_STAGE(PG8_SB(0, 1), cB + hstep, voffB); PG8_STAGE(PG8_SA(0, 0), cA, voffA); PG8_STAGE(PG8_SA(0, 1), cA + hstep, voffA);
        if (wr == 1) PG8_BAR;
        PG8_WAIT_V(2); PG8_BAR;
        PG8_STAGE(PG8_SB(1, 0), cB + kstep, voffB); PG8_STAGE(PG8_SA(1, 0), cA + kstep, voffA); PG8_STAGE(PG8_SB(1, 1), cB + hstep + kstep, voffB);
        PG8_WAIT_V(6); PG8_BAR;
    } else {
        PG8_STAGE(PG8_SB(0, 0), cB, voffB); PG8_STAGE(PG8_SA(0, 0), cA, voffA); PG8_STAGE(PG8_SB(0, 1), cB + hstep, voffB); PG8_STAGE(PG8_SA(0, 1), cA + hstep, voffA);
        if (wr == 1) PG8_BAR;
        PG8_WAIT_V(4); PG8_BAR;
        PG8_STAGE(PG8_SB(1, 0), cB + kstep, voffB); PG8_STAGE(PG8_SA(1, 0), cA + kstep, voffA); PG8_STAGE(PG8_SB(1, 1), cB + hstep + kstep, voffB);
        PG8_WAIT_V(6); PG8_BAR;
    }
    for (;;) {
        const bool has_next = S.next(ui + 1, nxt);
        const char* nA = has_next ? (const char*)g.A + (size_t)nxt.pm * g.a_tstep : cA; const char* nB = has_next ? (const char*)g.Bt + (size_t)nxt.pn * tstep : cB;
        for (int t = 0; t < nt; t += 2) {
            const bool last = (t == nt - 2);
            const char* a1 = cA + (size_t)(t + 1) * kstep;
            const char* a2 = last ? nA : cA + (size_t)(t + 2) * kstep; const char* b2 = last ? nB : cB + (size_t)(t + 2) * kstep;
            const char* a3 = a2 + kstep; const char* b3 = b2 + kstep;
            if (last && has_next) S.a_ready(nxt);
            if constexpr (SP2) {
            PG8_LDB(B0, 0, 0); PG8_LDB(B1, 0, 1); PG8_SCHED; PG8_LDA(At, 0, 0); PG8_STAGE(PG8_SA(1, 1), a1 + hstep, voffA);
            PG8_WAIT_V(8); PG8_WAIT_L(0); PG8_BAR; PG8_MMA(0, 0, At, B0); PG8_MMA(0, 1, At, B1); PG8_BAR; PG8_SCHED;
            PG8_LDA(At, 0, 1); PG8_STAGE(PG8_SB(0, 0), b2, voffB); PG8_STAGE(PG8_SB(0, 1), b2 + hstep, voffB); PG8_STAGE(PG8_SA(0, 0), a2, voffA);
            PG8_WAIT_V(8); PG8_WAIT_L(0); PG8_BAR; PG8_MMA(1, 0, At, B0); PG8_MMA(1, 1, At, B1); PG8_BAR; PG8_SCHED;
            PG8_LDB(B0, 1, 0); PG8_LDB(B1, 1, 1); PG8_SCHED; PG8_LDA(At, 1, 0); PG8_STAGE(PG8_SA(0, 1), a2 + hstep, voffA);
            PG8_WAIT_V(8); PG8_WAIT_L(0); PG8_BAR; PG8_MMA(0, 0, At, B0); PG8_MMA(0, 1, At, B1); PG8_BAR; PG8_SCHED;
            PG8_LDA(At, 1, 1); PG8_STAGE(PG8_SB(1, 0), b3, voffB); PG8_STAGE(PG8_SB(1, 1), b3 + hstep, voffB); PG8_STAGE(PG8_SA(1, 0), a3, voffA);
            PG8_WAIT_V(8); PG8_WAIT_L(0); PG8_BAR; PG8_MMA(1, 0, At, B0); PG8_MMA(1, 1, At, B1); PG8_BAR; PG8_SCHED;
            } else {
            PG8_LDB(B0, 0, 0); PG8_SCHED; PG8_LDA(At, 0, 0); PG8_STAGE(PG8_SA(1, 1), a1 + hstep, voffA);
            PG8_WAIT_L(8); PG8_BAR; PG8_WAIT_L(0); PG8_MMA(0, 0, At, B0); PG8_BAR; PG8_SCHED;
            PG8_LDB(B1, 0, 1); PG8_STAGE(PG8_SB(0, 0), b2, voffB);
            PG8_BAR; PG8_WAIT_L(0); PG8_MMA(0, 1, At, B1); PG8_BAR;
            PG8_LDA(At, 0, 1); PG8_STAGE(PG8_SA(0, 0), a2, voffA);
            PG8_BAR; PG8_WAIT_L(0); PG8_MMA(1, 0, At, B0); PG8_BAR; PG8_SCHED;
            PG8_STAGE(PG8_SB(0, 1), b2 + hstep, voffB);
            PG8_WAIT_V(6); PG8_BAR; PG8_MMA(1, 1, At, B1); PG8_BAR;
            PG8_LDB(B0, 1, 0); PG8_SCHED; PG8_LDA(At, 1, 0); PG8_STAGE(PG8_SA(0, 1), a2 + hstep, voffA);
            PG8_WAIT_L(8); PG8_BAR; PG8_WAIT_L(0); PG8_MMA(0, 0, At, B0); PG8_BAR; PG8_SCHED;
            PG8_LDB(B1, 1, 1); PG8_STAGE(PG8_SB(1, 0), b3, voffB);
            PG8_BAR; PG8_WAIT_L(0); PG8_MMA(0, 1, At, B1); PG8_BAR;
            PG8_LDA(At, 1, 1); PG8_STAGE(PG8_SA(1, 0), a3, voffA);
            PG8_BAR; PG8_WAIT_L(0); PG8_MMA(1, 0, At, B0); PG8_BAR; PG8_SCHED;
            PG8_STAGE(PG8_SB(1, 1), b3 + hstep, voffB);
            PG8_WAIT_V(6); PG8_BAR; PG8_MMA(1, 1, At, B1); PG8_BAR;
            }
        }
        if constexpr (ALIGN_EPI) { if (wr == 0) PG8_BAR; }
        if constexpr (!Epi::AFTER_DRAIN) { E(acc, cur, wr, wc, fr, fq); S.done(cur); }
        if (!has_next) break;
#pragma unroll
        for (int a = 0; a < 2; ++a)
#pragma unroll
            for (int b = 0; b < 2; ++b)
#pragma unroll
                for (int m = 0; m < 4; ++m)
#pragma unroll
                    for (int n = 0; n < 2; ++n) acc[a][b][m][n] = (f32x4){0.f, 0.f, 0.f, 0.f};
        cur = nxt; cA = nA; cB = nB; ++ui;
        if constexpr (ALIGN_EPI) { if (wr == 1) PG8_BAR; }
    }
    PG8_WAIT_V(0);
    if constexpr (!ALIGN_EPI) { if (wr == 0) PG8_BAR; }
    PG8_BAR;
    if constexpr (Epi::AFTER_DRAIN) { E.fused(acc, cur, wr, wc, fr, fq, lds, wid, lane); S.done(cur); }
#undef PG8_SA
#undef PG8_SB
#undef PG8_STAGE
#undef PG8_LDA
#undef PG8_LDB
#undef PG8_MMA
#undef PG8_WAIT_V
#undef PG8_WAIT_L
#undef PG8_BAR
#undef PG8_SCHED
}


struct EpiY {
    static constexpr bool PERM = true, AFTER_DRAIN = false;
    bf16_t* O;
    DI void operator()(const f32x4 (&acc)[2][2][4][2], const Unit& u, int wr, int wc, int fr, int fq) const {
        const int row0 = u.pm * BM + wr * 64 + fr, col0 = u.pn * BM + wc * 32 + 8 * fq;
#pragma unroll
        for (int ai = 0; ai < 2; ++ai)
#pragma unroll
            for (int m = 0; m < 4; ++m) {
                bf16_t* rowp = O + (size_t)(row0 + ai * HALF + m * 16) * D + col0;
#pragma unroll
                for (int bj = 0; bj < 2; ++bj) {
                    const f32x4 v0 = acc[ai][bj][m][0], v1 = acc[ai][bj][m][1];
                    u32x4 w; w.x = pack2(v0[0], v0[1]); w.y = pack2(v0[2], v0[3]); w.z = pack2(v1[0], v1[1]); w.w = pack2(v1[2], v1[3]);
                    *(u32x4*)(rowp + bj * HALF) = w;
                }
            }
    }
};
struct EpiIn {
    static constexpr bool PERM = true, AFTER_DRAIN = false;
    bf16_t* P; int even; const float* qg; const float* kg;
    DI void operator()(const f32x4 (&acc)[2][2][4][2], const Unit& u, int wr, int wc, int fr_in, int fq_in) const {
        int fr = fr_in, fq = fq_in;
        asm volatile("" : "+v"(fr), "+v"(fq));
        const int cb = u.pn * 256 + wc * 64;
        bf16_t* dst; int ld, dcol; const float* gain = nullptr; bool rope = false; float scale = 1.f;
        if (even) {
            if (cb < 512) { dst = P; ld = 512; dcol = cb; }
            else if (cb < 1024) { dst = P + (size_t)NR * 512; ld = 512; dcol = cb - 512; rope = true; scale = QSCALE; }
            else if (cb < 1152) { dst = P + (size_t)NR * 1024; ld = 128; dcol = cb - 1024; rope = true; }
            else { dst = P + (size_t)NR * 1152; ld = 128; dcol = cb - 1152; }
        } else {
            if (cb < 1024) { dst = P; ld = 1024; dcol = cb; gain = qg; rope = true; scale = QSCALE; }
            else if (cb < 1280) { dst = P + (size_t)NR * 1024; ld = 256; dcol = cb - 1024; gain = kg; rope = true; }
            else { dst = P + (size_t)NR * 1280; ld = 256; dcol = cb - 1280; }
        }
        f32x4 gn[2][2];
#pragma unroll
        for (int bj = 0; bj < 2; ++bj)
#pragma unroll
            for (int n = 0; n < 2; ++n) gn[bj][n] = gain ? *(const f32x4*)(gain + 32 * bj + 8 * fq + 4 * n) : (f32x4){1.f, 1.f, 1.f, 1.f};
#pragma unroll
        for (int ai = 0; ai < 2; ++ai)
#pragma unroll
            for (int m = 0; m < 4; ++m) {
                const int row = u.pm * BM + ai * HALF + wr * 64 + m * 16 + fr;
                f32x4 x[2][2];
#pragma unroll
                for (int bj = 0; bj < 2; ++bj)
#pragma unroll
                    for (int n = 0; n < 2; ++n) x[bj][n] = acc[ai][bj][m][n];
                if (gain) {
                    float ss = 0.f;
#pragma unroll
                    for (int bj = 0; bj < 2; ++bj)
#pragma unroll
                        for (int n = 0; n < 2; ++n)
#pragma unroll
                            for (int e = 0; e < 4; ++e) ss += x[bj][n][e] * x[bj][n][e];
                    ss += shx(ss, 16, fq * 16 + fr); ss += shx(ss, 32, fq * 16 + fr);
                    const float rinv = rsqrtf(ss * (1.0f / 64.0f) + EPS);
#pragma unroll
                    for (int bj = 0; bj < 2; ++bj)
#pragma unroll
                        for (int n = 0; n < 2; ++n) x[bj][n] = x[bj][n] * rinv * gn[bj][n];
                }
                if (rope && row < NLAT) {
                    const int t = row & (T - 1), pr = t >> 6, pc = t & 63;
                    const int idx = (fq < 2) ? (pr * 16 + 8 * fq) : (pc * 16 + 8 * fq - 16);
#pragma unroll
                    for (int n = 0; n < 2; ++n) {
                        const f32x4 cs = *(const f32x4*)(ROPE_COS + idx + 4 * n), sn = *(const f32x4*)(ROPE_SIN + idx + 4 * n);
                        const f32x4 x1 = x[0][n], x2 = x[1][n];
                        x[0][n] = x1 * cs - x2 * sn;
                        x[1][n] = x2 * cs + x1 * sn;
                    }
                }
                bf16_t* rp = dst + (size_t)row * ld + dcol + 8 * fq;
#pragma unroll
                for (int bj = 0; bj < 2; ++bj) {
                    const f32x4 v0 = x[bj][0] * scale, v1 = x[bj][1] * scale;
                    u32x4 w; w.x = pack2(v0[0], v0[1]); w.y = pack2(v0[2], v0[3]); w.z = pack2(v1[0], v1[1]); w.w = pack2(v1[2], v1[3]);
                    *(u32x4*)(rp + 32 * bj) = w;
                }
            }
    }
};
template <int DIR> DI void dpp_rot4(f32x4& r, const f32x4& x) {
    float r0, r1, r2, r3;
    if (DIR == 0)
        asm("s_nop 1\n\tv_mov_b32_dpp %0, %4 row_ror:1 row_mask:0xf bank_mask:0xf\n\tv_mov_b32_dpp %1, %5 row_ror:1 row_mask:0xf bank_mask:0xf\n\t"
            "v_mov_b32_dpp %2, %6 row_ror:1 row_mask:0xf bank_mask:0xf\n\tv_mov_b32_dpp %3, %7 row_ror:1 row_mask:0xf bank_mask:0xf"
            : "=&v"(r0), "=&v"(r1), "=&v"(r2), "=&v"(r3) : "v"(x[0]), "v"(x[1]), "v"(x[2]), "v"(x[3]));
    else
        asm("s_nop 1\n\tv_mov_b32_dpp %0, %4 row_ror:15 row_mask:0xf bank_mask:0xf\n\tv_mov_b32_dpp %1, %5 row_ror:15 row_mask:0xf bank_mask:0xf\n\t"
            "v_mov_b32_dpp %2, %6 row_ror:15 row_mask:0xf bank_mask:0xf\n\tv_mov_b32_dpp %3, %7 row_ror:15 row_mask:0xf bank_mask:0xf"
            : "=&v"(r0), "=&v"(r1), "=&v"(r2), "=&v"(r3) : "v"(x[0]), "v"(x[1]), "v"(x[2]), "v"(x[3]));
    r[0] = r0; r[1] = r1; r[2] = r2; r[3] = r3;
}
struct EpiUp {
    static constexpr bool PERM = true, AFTER_DRAIN = false;
    bf16_t* G; const float* cw; const float* cbias; int nrows; lchar* ex; lchar* wl; const StaticOrder* S;
    DI float wfetch(int pn, int idx) const {
        const int tap = idx >> 8, pos = idx & 255;
        const int ch = (pos < 128) ? (128 * pn + pos) : (DFF + 128 * pn + pos - 128);
        return (tap < 3) ? cw[tap * DFF2 + ch] : cbias[ch];
    }
    DI void operator()(const f32x4 (&acc)[2][2][4][2], const Unit& u, int wr, int wc, int fr_in, int fq_in) const {
        int fr = fr_in, fq = fq_in;
        asm volatile("" : "+v"(fr), "+v"(fq));
        const int lane = fq * 16 + fr;
        const int tid_e = (wr * 4 + wc) * 64 + lane;
        Unit nxt; const bool has_nxt = S->next(u.seq + 1, nxt);
        float wn0 = 0.f, wn1 = 0.f;
        if (has_nxt) { wn0 = wfetch(nxt.pn, tid_e); wn1 = wfetch(nxt.pn, tid_e + 512); }
        const LAS float* wlb = (const LAS float*)(wl + (u.seq & 1) * 4096);
        LAS float* exb = (LAS float*)(ex + (u.seq & 1) * 8192);
        const int qpos = 32 * wc + 8 * fq;
#pragma unroll
        for (int ai = 0; ai < 2; ++ai) {
            const int blk = 2 * ai + wr;
            if (fr == 0) {
#pragma unroll
                for (int bj = 0; bj < 2; ++bj)
#pragma unroll
                    for (int n = 0; n < 2; ++n) *(LAS f32x4*)(exb + (blk * 2 + 0) * 256 + 128 * bj + qpos + 4 * n) = acc[ai][bj][0][n];
            }
            if (fr == 15) {
#pragma unroll
                for (int bj = 0; bj < 2; ++bj)
#pragma unroll
                    for (int n = 0; n < 2; ++n) *(LAS f32x4*)(exb + (blk * 2 + 1) * 256 + 128 * bj + qpos + 4 * n) = acc[ai][bj][3][n];
            }
        }
        asm volatile("s_waitcnt lgkmcnt(0)" ::: "memory"); __builtin_amdgcn_s_barrier(); asm volatile("" ::: "memory");
        const int ch = 128 * u.pn + qpos;
#pragma unroll
        for (int ai = 0; ai < 2; ++ai) {
            const int blk = 2 * ai + wr;
            const int tr0 = 128 * ai + 64 * wr + fr;
            u32x2 pk0[4];
#pragma unroll
            for (int n = 0; n < 2; ++n) {
                f32x4 ga[4];
#pragma unroll
                for (int bj = 0; bj < 2; ++bj) {
                    const LAS float* wp = wlb + 128 * bj + qpos + 4 * n;
                    const f32x4 w0 = *(const LAS f32x4*)(wp), w1 = *(const LAS f32x4*)(wp + 256), w2 = *(const LAS f32x4*)(wp + 512), bb = *(const LAS f32x4*)(wp + 768);
                    const f32x4 eprev = *(const LAS f32x4*)(exb + (((blk + 3) & 3) * 2 + 1) * 256 + 128 * bj + qpos + 4 * n);
                    const f32x4 enext = *(const LAS f32x4*)(exb + (((blk + 1) & 3) * 2 + 0) * 256 + 128 * bj + qpos + 4 * n);
#pragma unroll
                    for (int m = 0; m < 4; ++m) {
                        const int g = 254 * u.pm - 1 + tr0 + 16 * m;
                        const int lmask = (g < NLAT) ? (T - 1) : (CL - 1);
                        const bool hp = (g & lmask) != 0, hn = ((g + 1) & lmask) != 0;
                        f32x4 sp = acc[ai][bj][m][n], sn = acc[ai][bj][m][n];
                        if (m > 0 && fr == 15) sp = acc[ai][bj][m > 0 ? m - 1 : 0][n];
                        if (m < 3 && fr == 0) sn = acc[ai][bj][m < 3 ? m + 1 : 3][n];
                        f32x4 pv, nv;
                        dpp_rot4<0>(pv, sp); dpp_rot4<1>(nv, sn);
                        if (m == 0 && fr == 0) pv = eprev;
                        if (m == 3 && fr == 15) nv = enext;
                        if (!hp) pv = (f32x4){0.f, 0.f, 0.f, 0.f};
                        if (!hn) nv = (f32x4){0.f, 0.f, 0.f, 0.f};
                        const f32x4 uu = pv * w0 + acc[ai][bj][m][n] * w1 + nv * w2 + bb;
                        if (bj == 0) { ga[m][0] = gelu_tanh(uu[0]); ga[m][1] = gelu_tanh(uu[1]); ga[m][2] = gelu_tanh(uu[2]); ga[m][3] = gelu_tanh(uu[3]); }
                        else ga[m] = ga[m] * uu;
                        asm volatile("" : "+v"(ga[m][0]), "+v"(ga[m][1]), "+v"(ga[m][2]), "+v"(ga[m][3]));
                    }
                }
#pragma unroll
                for (int m = 0; m < 4; ++m) {
                    const int tr = tr0 + 16 * m;
                    const int g = 254 * u.pm - 1 + tr;
                    u32x2 w; w.x = pack2(ga[m][0], ga[m][1]); w.y = pack2(ga[m][2], ga[m][3]);
                    if (n == 0) pk0[m] = w;
                    else if (tr >= 1 && tr <= 254 && g < nrows) {
                        u32x4 w4; w4.x = pk0[m].x; w4.y = pk0[m].y; w4.z = w.x; w4.w = w.y;
                        *(u32x4*)(G + (size_t)g * DFF + ch) = w4;
                    }
                }
            }
        }
        if (has_nxt) { LAS float* wn = (LAS float*)(wl + ((u.seq + 1) & 1) * 4096); wn[tid_e] = wn0; wn[tid_e + 512] = wn1; }
    }
};

DI void phase_g1(const Params& p, int l, lchar* lds) {
    const bool even = (l & 1) == 0; const int li = l >> 1;
    Gemm g{p.H, p.wt_in(l), D, (size_t)BM * D * 2};
    StaticOrder S; S.init(NR / BM, even ? 5 : 6, gridDim.x, blockIdx.x);
    EpiIn E{p.PG, even ? 1 : 0, p.c_q_g + li * 64, p.c_k_g + li * 64};
    gemm_phase<EpiIn, StaticOrder, false, true>((LAS unsigned char*)lds, g, S, E);
}
DI void phase_gy(const Params& p, const bf16_t* A, int K, const bf16_t* Wt, int mtiles, lchar* lds) {
    Gemm g{A, Wt, K, (size_t)BM * K * 2};
    StaticOrder S; S.init(mtiles, 4, gridDim.x, blockIdx.x);
    EpiY E{p.Y};
    gemm_phase<EpiY, StaticOrder, false, true>((LAS unsigned char*)lds, g, S, E);
}
DI void phase_g3(const Params& p, int l, lchar* lds) {
    const int nrows = (l == 3) ? NLAT : NR;
    Gemm g{p.H - D, p.wt_up(l), D, (size_t)254 * D * 2};
    StaticOrder S; S.init((nrows + 253) / 254, 21, gridDim.x, blockIdx.x);
    EpiUp E{p.PG, p.ffn_conv_w + (size_t)l * 3 * DFF2, p.ffn_conv_b + (size_t)l * DFF2, nrows, lds + RING_BYTES, lds + RING_BYTES + EX_BYTES, &S};
    {
        Unit u0;
        if (S.next(0, u0)) { const int t = get_tid(); LAS float* w0p = (LAS float*)(lds + RING_BYTES + EX_BYTES); w0p[t] = E.wfetch(u0.pn, t); w0p[t + 512] = E.wfetch(u0.pn, t + 512); }
        __syncthreads();
    }
    gemm_phase<EpiUp, StaticOrder, true, true>((LAS unsigned char*)lds, g, S, E);
}

constexpr int KSTR = 144, VSTR = 192;
constexpr int KV_K = 64 * KSTR  , KV_BUF = KV_K + 64 * VSTR  ;

constexpr float ATT_THR = 8.0f;
template <int VAR>
DI void attn_unit(const bf16_t* __restrict__ Qb, int ldq, int qcol, int qrow0,
                  const bf16_t* __restrict__ Kb, const bf16_t* __restrict__ Vb, int ldkv, int kvcol,
                  int lat_row0, int nlat, int kpos0, int qpos0, bool masked,
                  int ctx_row0, int nctx, float m_init, float l_init0,
                  bf16_t* __restrict__ O, int ldo, int ocol, lchar* lds) {
    const int tid = get_tid(), lane = tid & 63, wave = tid >> 6, l31 = lane & 31, h = lane >> 5;
    const int ntiles = nlat + nctx;
    bf16x8 qf[4];
    {
        const bf16_t* qp = Qb + (size_t)(qrow0 + wave * 32 + l31) * ldq + qcol + 8 * h;
#pragma unroll
        for (int ks = 0; ks < 4; ++ks) qf[ks] = *(const bf16x8*)(qp + 16 * ks);
    }
    const int lrow = tid >> 3, lkc = tid & 7;
    auto tile_off = [&](int i) -> size_t {
        const int r0 = (i < nlat) ? (lat_row0 + 64 * i) : (ctx_row0 + 64 * (i - nlat));
        return (size_t)(r0 + lrow) * ldkv + kvcol + lkc * 8;
    };
    lchar* const Kbase = lds;
    lchar* const Vbase = lds + 2 * KV_K;
    constexpr int VB = 64 * VSTR;
    const int koff = lrow * KSTR + lkc * 16, voff = lrow * VSTR + lkc * 16;
    auto kload = [&](bf16x8 (&kf)[4][2], const lchar* Kl) {
#pragma unroll
        for (int ks = 0; ks < 4; ++ks)
#pragma unroll
            for (int kt = 0; kt < 2; ++kt) kf[ks][kt] = *(const LAS bf16x8*)(Kl + (32 * kt + l31) * KSTR + ks * 32 + h * 16);
    };
    auto qk = [&](f32x16 (&st)[2], const bf16x8 (&kf)[4][2], const f32x16& init) {
#pragma unroll
        for (int kt = 0; kt < 2; ++kt) st[kt] = MFMA32(kf[0][kt], qf[0], init);
#pragma unroll
        for (int ks = 1; ks < 4; ++ks)
#pragma unroll
            for (int kt = 0; kt < 2; ++kt) st[kt] = MFMA32(kf[ks][kt], qf[ks], st[kt]);
    };
    f32x16 negm;
    { const float z0 = opaque0();
#pragma unroll
      for (int i = 0; i < 16; ++i) negm[i] = z0; }
    const int qpos = qpos0 + wave * 32 + l31;
    auto apply_mask = [&](f32x16 (&st)[2], int it) {
        if (masked && it < nlat) {
            const int kp0 = kpos0 + 64 * it;
#pragma unroll
            for (int kt = 0; kt < 2; ++kt)
#pragma unroll
                for (int i = 0; i < 16; ++i) {
                    const int diff = qpos - (kp0 + 32 * kt + crow(i, h));
                    if (diff > 128 || diff < -128) st[kt][i] = -1e30f;
                }
        }
    };
    auto rowmax = [&](const f32x16 (&st)[2]) -> float {
        float mx = fmaxf(st[0][0], st[1][0]);
#pragma unroll
        for (int i = 1; i < 16; ++i) mx = fmaxf(mx, fmaxf(st[0][i], st[1][i]));
        return fmaxf(mx, shx(mx, 32, lane));
    };
    auto rowmax_fast = [&](const f32x16 (&st)[2]) -> float {
        float mx;
        asm("v_max3_f32 %0, %1, %2, %3" : "=v"(mx) : "v"(st[0][0]), "v"(st[0][1]), "v"(st[0][2]));
#pragma unroll
        for (int i = 3; i < 15; i += 2) asm("v_max3_f32 %0, %1, %2, %3" : "=v"(mx) : "v"(mx), "v"(st[0][i]), "v"(st[0][i + 1]));
        asm("v_max3_f32 %0, %1, %2, %3" : "=v"(mx) : "v"(mx), "v"(st[0][15]), "v"(st[1][0]));
#pragma unroll
        for (int i = 1; i < 15; i += 2) asm("v_max3_f32 %0, %1, %2, %3" : "=v"(mx) : "v"(mx), "v"(st[1][i]), "v"(st[1][i + 1]));
        asm("v_max_f32 %0, %1, %2" : "=v"(mx) : "v"(mx), "v"(st[1][15]));
        const float other = shx(mx, 32, lane);
        asm("v_max_f32 %0, %1, %2" : "=v"(mx) : "v"(mx), "v"(other));
        return mx;
    };
    {
        const u32x4 k0 = *(const u32x4*)(Kb + tile_off(0)), v0 = *(const u32x4*)(Vb + tile_off(0)), k1 = *(const u32x4*)(Kb + tile_off(1));
        *(LAS u32x4*)(Kbase + koff) = k0; *(LAS u32x4*)(Vbase + voff) = v0; *(LAS u32x4*)(Kbase + KV_K + koff) = k1;
    }
    __syncthreads();
    f32x16 o[2];
    { const float z0 = opaque0();
#pragma unroll
      for (int dt = 0; dt < 2; ++dt)
#pragma unroll
        for (int i = 0; i < 16; ++i) o[dt][i] = z0; }
    f32x16 sA[2], sB[2];
    { bf16x8 kf0[4][2]; kload(kf0, Kbase); qk(sA, kf0, negm); }
    apply_mask(sA, 0);
    float m_ref = fmaxf(m_init, rowmax(sA));
    float lsum = (h == 0) ? l_init0 * fast_exp2(m_init - m_ref) : 0.f;
#pragma unroll
    for (int kt = 0; kt < 2; ++kt)
#pragma unroll
        for (int i = 0; i < 16; ++i) sA[kt][i] -= m_ref;
#pragma unroll
    for (int i = 0; i < 16; ++i) negm[i] = -m_ref;
    auto step = [&](f32x16 (&sc)[2], f32x16 (&sn)[2], int it, u32x4& ldk, u32x4& ldv, const u32x4& stk, const u32x4& stv) {
        const int i3 = min(it + 3, ntiles - 1), i2 = min(it + 2, ntiles - 1);
        if (VAR != 4) { *(LAS u32x4*)(Kbase + (it & 1) * KV_K + koff) = stk; *(LAS u32x4*)(Vbase + ((it + 1) & 1) * VB + voff) = stv; }
        if (VAR != 4) { ldk = *(const u32x4*)(Kb + tile_off(i3)); ldv = *(const u32x4*)(Vb + tile_off(i2)); }
        bf16x8 kf[4][2]; kload(kf, Kbase + ((it + 1) & 1) * KV_K);
        const float mx = rowmax_fast(sc);
        if (__builtin_amdgcn_ballot_w64(mx > ATT_THR) != 0ull) {
            const float delta = fmaxf(mx, 0.f), alpha = fast_exp2(-delta);
#pragma unroll
            for (int dt = 0; dt < 2; ++dt)
#pragma unroll
                for (int i = 0; i < 16; ++i) o[dt][i] *= alpha;
            lsum *= alpha;
#pragma unroll
            for (int kt = 0; kt < 2; ++kt)
#pragma unroll
                for (int i = 0; i < 16; ++i) sc[kt][i] -= delta;
            m_ref += delta;
#pragma unroll
            for (int i = 0; i < 16; ++i) negm[i] = -m_ref;
        }
        if (VAR != 2) qk(sn, kf, negm); else { sn[0] = sc[0]; sn[1] = sc[1]; }
        bf16x8 vf[4][2];
        {
            const lchar* Vl = Vbase + (it & 1) * VB;
            const int qq = (lane & 15) >> 2, pp = lane & 3, g16 = (lane >> 4) & 1;
            const lchar* vb = Vl + (4 * h + qq) * VSTR + (16 * g16 + 4 * pp) * 2;
#pragma unroll
            for (int s = 0; s < 4; ++s)
#pragma unroll
                for (int dt = 0; dt < 2; ++dt) {
                    const s16x4 lo = __builtin_amdgcn_ds_read_tr16_b64_v4i16((LAS s16x4*)(vb + (16 * s) * VSTR + dt * 64));
                    const s16x4 hi = __builtin_amdgcn_ds_read_tr16_b64_v4i16((LAS s16x4*)(vb + (16 * s + 8) * VSTR + dt * 64));
                    vf[s][dt] = __builtin_shufflevector(lo, hi, 0, 1, 2, 3, 4, 5, 6, 7);
                }
        }
        float ps = 0.f;
#pragma unroll
        for (int kt = 0; kt < 2; ++kt)
#pragma unroll
            for (int i = 0; i < 16; ++i) { const float pv = (VAR == 1) ? sc[kt][i] : fast_exp2(sc[kt][i]); sc[kt][i] = pv; ps += pv; }
        lsum += ps;
        bf16x8 pf[4];
#pragma unroll
        for (int s = 0; s < 4; ++s) {
            u32x4 w;
            const int kt = s >> 1, b = 8 * (s & 1);
            w.x = pack2(sc[kt][b + 0], sc[kt][b + 1]); w.y = pack2(sc[kt][b + 2], sc[kt][b + 3]);
            w.z = pack2(sc[kt][b + 4], sc[kt][b + 5]); w.w = pack2(sc[kt][b + 6], sc[kt][b + 7]);
            pf[s] = __builtin_bit_cast(bf16x8, w);
        }
#pragma unroll
        for (int s = 0; s < 4; ++s)
#pragma unroll
            for (int dt = 0; dt < 2; ++dt) { if (VAR != 3) o[dt] = MFMA32(vf[s][dt], pf[s], o[dt]); else o[dt][s] += __builtin_bit_cast(float, (int)pf[s][dt]) + __builtin_bit_cast(float, (int)vf[s][dt][0]); }
        apply_mask(sn, it + 1);
        if (VAR != 5) __syncthreads();
    };
    u32x4 rkA, rvA, rkB, rvB;
    rkB = *(const u32x4*)(Kb + tile_off(min(2, ntiles - 1)));
    rvB = *(const u32x4*)(Vb + tile_off(1));
    for (int it = 0; it < ntiles; it += 2) { step(sA, sB, it, rkA, rvA, rkB, rvB); step(sB, sA, it + 1, rkB, rvB, rkA, rvA); }
    const float ltot = lsum + shx(lsum, 32, lane);
    const float inv = 1.0f / ltot;
    bf16_t* op = O + (size_t)(qrow0 + wave * 32 + l31) * ldo + ocol + 4 * h;
#pragma unroll
    for (int dt = 0; dt < 2; ++dt)
#pragma unroll
        for (int g = 0; g < 4; ++g) {
            u32x2 w;
            w.x = pack2(o[dt][4 * g] * inv, o[dt][4 * g + 1] * inv); w.y = pack2(o[dt][4 * g + 2] * inv, o[dt][4 * g + 3] * inv);
            *(u32x2*)(op + 32 * dt + 8 * g) = w;
        }
}

template <bool FIRST, bool MASKED>
DI void attn2_step(f32x16 (&o)[2][2], float (&m_ref)[2], float (&lsum)[2], const bf16x8 (&qf)[2][4], const lchar* Kl, const lchar* Vl, int lane, int kp0, int qw0, float m_init, float l0) {
    const int l31 = lane & 31, h = lane >> 5;
    if (MASKED && kp0 >= 0 && (kp0 + 63 < qw0 - 128 || kp0 > qw0 + 63 + 128)) {
        if (FIRST) {
#pragma unroll
            for (int q = 0; q < 2; ++q) { m_ref[q] = m_init; lsum[q] = (h == 0) ? l0 : 0.f; }
        }
        return;
    }
    bf16x8 kf[4][2];
#pragma unroll
    for (int ks = 0; ks < 4; ++ks)
#pragma unroll
        for (int kt = 0; kt < 2; ++kt) kf[ks][kt] = *(const LAS bf16x8*)(Kl + (32 * kt + l31) * KSTR + ks * 32 + h * 16);
    f32x16 sc[2][2];
#pragma unroll
    for (int q = 0; q < 2; ++q) {
        const float init = FIRST ? opaque0() : -m_ref[q];
#pragma unroll
        for (int kt = 0; kt < 2; ++kt)
#pragma unroll
            for (int i = 0; i < 16; ++i) sc[q][kt][i] = init;
#pragma unroll
        for (int ks = 0; ks < 4; ++ks)
#pragma unroll
            for (int kt = 0; kt < 2; ++kt) sc[q][kt] = MFMA32(kf[ks][kt], qf[q][ks], sc[q][kt]);
    }
    if (MASKED && kp0 >= 0 && !(kp0 >= qw0 + 63 - 128 && kp0 + 63 <= qw0 + 128)) {
#pragma unroll
        for (int q = 0; q < 2; ++q) {
            const int qpos = qw0 + q * 32 + l31;
#pragma unroll
            for (int kt = 0; kt < 2; ++kt)
#pragma unroll
                for (int i = 0; i < 16; ++i) {
                    const int diff = qpos - (kp0 + 32 * kt + crow(i, h));
                    if (diff > 128 || diff < -128) sc[q][kt][i] = -1e30f;
                }
        }
    }
    float mx[2];
#pragma unroll
    for (int q = 0; q < 2; ++q) {
        float m = fmaxf(sc[q][0][0], sc[q][1][0]);
#pragma unroll
        for (int i = 1; i < 16; ++i) m = fmaxf(m, fmaxf(sc[q][0][i], sc[q][1][i]));
        mx[q] = fmaxf(m, shx(m, 32, lane));
    }
    if (FIRST) {
#pragma unroll
        for (int q = 0; q < 2; ++q) {
            m_ref[q] = fmaxf(m_init, mx[q]);
            lsum[q] = (h == 0) ? l0 * fast_exp2(m_init - m_ref[q]) : 0.f;
#pragma unroll
            for (int kt = 0; kt < 2; ++kt)
#pragma unroll
                for (int i = 0; i < 16; ++i) sc[q][kt][i] -= m_ref[q];
        }
    } else if (__builtin_amdgcn_ballot_w64(fmaxf(mx[0], mx[1]) > ATT_THR) != 0ull) {
#pragma unroll
        for (int q = 0; q < 2; ++q) {
            const float delta = fmaxf(mx[q], 0.f), alpha = fast_exp2(-delta);
#pragma unroll
            for (int dt = 0; dt < 2; ++dt)
#pragma unroll
                for (int i = 0; i < 16; ++i) o[q][dt][i] *= alpha;
            lsum[q] *= alpha;
#pragma unroll
            for (int kt = 0; kt < 2; ++kt)
#pragma unroll
                for (int i = 0; i < 16; ++i) sc[q][kt][i] -= delta;
            m_ref[q] += delta;
        }
    }
    bf16x8 pf[2][4];
#pragma unroll
    for (int q = 0; q < 2; ++q) {
        float ps = 0.f;
#pragma unroll
        for (int kt = 0; kt < 2; ++kt)
#pragma unroll
            for (int i = 0; i < 16; ++i) { const float pv = fast_exp2(sc[q][kt][i]); sc[q][kt][i] = pv; ps += pv; }
        lsum[q] += ps;
#pragma unroll
        for (int s = 0; s < 4; ++s) {
            u32x4 w;
            const int kt = s >> 1, b = 8 * (s & 1);
            w.x = pack2(sc[q][kt][b + 0], sc[q][kt][b + 1]); w.y = pack2(sc[q][kt][b + 2], sc[q][kt][b + 3]);
            w.z = pack2(sc[q][kt][b + 4], sc[q][kt][b + 5]); w.w = pack2(sc[q][kt][b + 6], sc[q][kt][b + 7]);
            pf[q][s] = __builtin_bit_cast(bf16x8, w);
        }
    }
    {
        const int qq = (lane & 15) >> 2, pp = lane & 3, g16 = (lane >> 4) & 1;
        const lchar* vb = Vl + (4 * h + qq) * VSTR + (16 * g16 + 4 * pp) * 2;
#pragma unroll
        for (int s = 0; s < 4; ++s)
#pragma unroll
            for (int dt = 0; dt < 2; ++dt) {
                const s16x4 lo = __builtin_amdgcn_ds_read_tr16_b64_v4i16((LAS s16x4*)(vb + (16 * s) * VSTR + dt * 64));
                const s16x4 hi = __builtin_amdgcn_ds_read_tr16_b64_v4i16((LAS s16x4*)(vb + (16 * s + 8) * VSTR + dt * 64));
                const bf16x8 vf = __builtin_shufflevector(lo, hi, 0, 1, 2, 3, 4, 5, 6, 7);
#pragma unroll
                for (int q = 0; q < 2; ++q) o[q][dt] = MFMA32(vf, pf[q][s], o[q][dt]);
            }
    }
}
template <bool MASKED>
DI void attn_unit2(const bf16_t* __restrict__ Qb, int ldq, int qcol, int qrow0,
                   const bf16_t* __restrict__ Kb, const bf16_t* __restrict__ Vb, int ldkv, int kvcol,
                   int lat_row0, int nlat, int kpos0, int qpos0, int ctx_row0, int nctx, float m_init, float l0,
                   bf16_t* __restrict__ O, int ldo, int ocol, lchar* lds) {
    const int tid = get_tid(), lane = tid & 63, wave = tid >> 6, l31 = lane & 31, h = lane >> 5;
    const int ntiles = nlat + nctx;
    bf16x8 qf[2][4];
#pragma unroll
    for (int q = 0; q < 2; ++q) {
        const bf16_t* qp = Qb + (size_t)(qrow0 + wave * 64 + q * 32 + l31) * ldq + qcol + 8 * h;
#pragma unroll
        for (int ks = 0; ks < 4; ++ks) qf[q][ks] = *(const bf16x8*)(qp + 16 * ks);
    }
    const int lrow = tid >> 3, lkc = tid & 7;
    auto tile_off = [&](int i) -> size_t {
        const int r0 = (i < nlat) ? (lat_row0 + 64 * i) : (ctx_row0 + 64 * (i - nlat));
        return (size_t)(r0 + lrow) * ldkv + kvcol + lkc * 8;
    };
    lchar* const Kbase = lds; lchar* const Vbase = lds + 2 * KV_K;
    constexpr int VB = 64 * VSTR;
    const int koff = lrow * KSTR + lkc * 16, voff = lrow * VSTR + lkc * 16;
    f32x16 o[2][2];
    { const float z0 = opaque0();
#pragma unroll
      for (int q = 0; q < 2; ++q)
#pragma unroll
        for (int dt = 0; dt < 2; ++dt)
#pragma unroll
            for (int i = 0; i < 16; ++i) o[q][dt][i] = z0; }
    float m_ref[2] = {0.f, 0.f}, lsum[2] = {0.f, 0.f};
    const int qw0 = __builtin_amdgcn_readfirstlane(qpos0 + wave * 64);
    u32x4 rk, rv;
    {
        const u32x4 k0 = *(const u32x4*)(Kb + tile_off(0)), v0 = *(const u32x4*)(Vb + tile_off(0));
        rk = *(const u32x4*)(Kb + tile_off(1)); rv = *(const u32x4*)(Vb + tile_off(1));
        *(LAS u32x4*)(Kbase + koff) = k0; *(LAS u32x4*)(Vbase + voff) = v0;
    }
    __syncthreads();
    {
        *(LAS u32x4*)(Kbase + KV_K + koff) = rk; *(LAS u32x4*)(Vbase + VB + voff) = rv;
        rk = *(const u32x4*)(Kb + tile_off(2)); rv = *(const u32x4*)(Vb + tile_off(2));
        attn2_step<true, MASKED>(o, m_ref, lsum, qf, Kbase, Vbase, lane, kpos0, qw0, m_init, l0);
        __syncthreads();
    }
    for (int it = 1; it < ntiles; ++it) {
        *(LAS u32x4*)(Kbase + ((it + 1) & 1) * KV_K + koff) = rk; *(LAS u32x4*)(Vbase + ((it + 1) & 1) * VB + voff) = rv;
        const int i2 = min(it + 2, ntiles - 1);
        rk = *(const u32x4*)(Kb + tile_off(i2)); rv = *(const u32x4*)(Vb + tile_off(i2));
        attn2_step<false, MASKED>(o, m_ref, lsum, qf, Kbase + (it & 1) * KV_K, Vbase + (it & 1) * VB, lane, (it < nlat) ? kpos0 + 64 * it : -1, qw0, m_init, l0);
        __syncthreads();
    }
#pragma unroll
    for (int q = 0; q < 2; ++q) {
        const float ltot = lsum[q] + shx(lsum[q], 32, lane);
        const float inv = 1.0f / ltot;
        bf16_t* op = O + (size_t)(qrow0 + wave * 64 + q * 32 + l31) * ldo + ocol + 4 * h;
#pragma unroll
        for (int dt = 0; dt < 2; ++dt)
#pragma unroll
            for (int g = 0; g < 4; ++g) {
                u32x2 w;
                w.x = pack2(o[q][dt][4 * g] * inv, o[q][dt][4 * g + 1] * inv); w.y = pack2(o[q][dt][4 * g + 2] * inv, o[q][dt][4 * g + 3] * inv);
                *(u32x2*)(op + 32 * dt + 8 * g) = w;
            }
    }
}

constexpr int PSTR = 272;
DI void pool_unit(const Params& p, int li, int m0, int g, lchar* lds) {
    const int tid = get_tid(), lane = tid & 63, wave = tid >> 6, wm = wave & 1, wn = wave >> 1, l31 = lane & 31, h = lane >> 5;
    const bf16_t* U = p.PG;
    bf16_t* MIX = p.PG + (size_t)NR * 1536;
    int seq0, L;
    if (m0 < NLAT) { seq0 = m0 & ~(T - 1); L = T; } else { seq0 = NLAT + ((m0 - NLAT) & ~(CL - 1)); L = CL; }
    const int tl0 = m0 - seq0;
    lchar* Ur = lds;
    lchar* Dt = lds + 144 * 256;
    for (int c = tid; c < 144 * 16; c += NTHR) {
        const int j = c >> 4, ch = c & 15; const int t = tl0 - 8 + j;
        u32x4 v = (u32x4){0u, 0u, 0u, 0u};
        if (t >= 0 && t < L) v = *(const u32x4*)(U + (size_t)(seq0 + t) * 512 + g * 128 + ch * 8);
        *(LAS u32x4*)(Ur + j * 256 + ch * 16) = v;
    }
    __syncthreads();
    {
        const int hw = 1 << g;
        const int cp = tid & 63, rs = tid >> 6;
        const LAS unsigned* up = (const LAS unsigned*)Ur + cp;
        int t = tl0 + rs * 16;
        float s0 = 0.f, s1 = 0.f;
        for (int tt = t - hw; tt < t + hw; ++tt) {
            if (tt >= 0 && tt < L) { const unsigned w = up[(tt - tl0 + 8) * 64]; s0 += bf2f(w & 0xffffu); s1 += bf2f(w >> 16); }
        }
        for (int r = 0; r < 16; ++r, ++t) {
            const int lo = max(t - hw, 0), hi = min(t + hw, L);
            const float ic = 1.0f / (float)(hi - lo);
            const unsigned wc = up[(t - tl0 + 8) * 64];
            const float d0 = s0 * ic - bf2f(wc & 0xffffu), d1 = s1 * ic - bf2f(wc >> 16);
            *(LAS unsigned*)(Dt + (rs * 16 + r) * PSTR + cp * 4) = pack2(d0, d1);
            const int ta = t + hw, tr = t - hw;
            if (ta < L) { const unsigned w = up[(ta - tl0 + 8) * 64]; s0 += bf2f(w & 0xffffu); s1 += bf2f(w >> 16); }
            if (tr >= 0) { const unsigned w = up[(tr - tl0 + 8) * 64]; s0 -= bf2f(w & 0xffffu); s1 -= bf2f(w >> 16); }
        }
    }
    __syncthreads();
    f32x16 acc[2];
    { const float z0 = opaque0();
#pragma unroll
      for (int mt = 0; mt < 2; ++mt)
#pragma unroll
        for (int i = 0; i < 16; ++i) acc[mt][i] = z0; }
    const bf16_t* W = p.wt_pool(li) + (size_t)g * 128 * 128;
#pragma unroll
    for (int ks = 0; ks < 8; ++ks) {
        bf16x8 xf[2];
#pragma unroll
        for (int mt = 0; mt < 2; ++mt) xf[mt] = *(const LAS bf16x8*)(Dt + (wm * 64 + mt * 32 + l31) * PSTR + ks * 32 + h * 16);
        const bf16x8 wf = *(const bf16x8*)(W + (size_t)(wn * 32 + l31) * 128 + ks * 16 + h * 8);
#pragma unroll
        for (int mt = 0; mt < 2; ++mt) acc[mt] = MFMA32(wf, xf[mt], acc[mt]);
    }
    const float* sc = p.pool_scale + li * 512 + g * 128 + wn * 32;
#pragma unroll
    for (int mt = 0; mt < 2; ++mt) {
        const int row = m0 + wm * 64 + mt * 32 + l31;
        bf16_t* rp = MIX + (size_t)row * D + g * 128 + wn * 32 + 4 * h;
#pragma unroll
        for (int gg = 0; gg < 4; ++gg) {
            const f32x4 s4 = *(const f32x4*)(sc + 8 * gg + 4 * h);
            u32x2 w;
            w.x = pack2(acc[mt][4 * gg] * s4[0], acc[mt][4 * gg + 1] * s4[1]);
            w.y = pack2(acc[mt][4 * gg + 2] * s4[2], acc[mt][4 * gg + 3] * s4[3]);
            *(u32x2*)(rp + 8 * gg) = w;
        }
    }
    __syncthreads();
}

template <int VAR>
DI void phase_mixer(const Params& p, int l, lchar* lds) {
    const bool even = (l & 1) == 0; const int li = l >> 1;
    const bool need_ctx = l < 3;
    bf16_t* P = p.PG; bf16_t* MIX = p.PG + (size_t)NR * 1536;
    const bf16_t *Q, *Kb, *Vb; int ldq, ldkv, n_lat, n_ctx, ocol0;
    if (even) { Q = P + (size_t)NR * 512; Kb = P + (size_t)NR * 1024; Vb = P + (size_t)NR * 1152; ldq = 512; ldkv = 128; n_lat = NB * 8 * 8; n_ctx = NB * 8; ocol0 = 512; }
    else { Q = P; Kb = P + (size_t)NR * 1024; Vb = P + (size_t)NR * 1280; ldq = 1024; ldkv = 256; n_lat = NB * 4 * 8 * 4; n_ctx = need_ctx ? NB * 16 : 0; ocol0 = 0; }
    for (int id = blockIdx.x; id < n_lat + n_ctx; id += gridDim.x) {
        int hd, b, qrow0, lat_row0 = 0, nlat = 0, kpos0 = 0, qpos0 = 0; bool masked = false;
        if (id < n_lat) {
            int nb;
            if (even) {
                const int hd2 = id & 7, nb2 = (id >> 3) & 7, b2 = id >> 6, start2 = nb2 * 512;
                int kf2 = start2 - 128, kl2 = start2 + 512 + 128;
                if (kf2 < 0) kf2 = 0;
                if (kl2 > T) kl2 = T;
                attn_unit2<true>(Q, ldq, hd2 * 64, b2 * T + start2, Kb, Vb, ldkv, (hd2 >> 2) * 64, b2 * T + kf2, (kl2 - kf2) >> 6, kf2, start2, NLAT + b2 * CL, 4,
                                 p.sink_logit[li * 8 + hd2] * LOG2E, 1.0f, MIX, D, ocol0 + hd2 * 64, lds);
                continue;
            }
            else {
                const int gq = id & 3, nb2 = (id >> 2) & 7, kvh_ = (id >> 5) & 3, b2 = id >> 7, hd2 = kvh_ * 4 + gq;
                attn_unit2<false>(Q, ldq, hd2 * 64, b2 * T + nb2 * 512, Kb, Vb, ldkv, kvh_ * 64, b2 * T, 64, 0, 0, NLAT + b2 * CL, 4, -1e30f, 0.f, MIX, D, ocol0 + hd2 * 64, lds);
                continue;
            }
            const int start = nb * 256;
            qrow0 = b * T + start;
            if (even) {
                int kfirst = start - 128, klast = start + 256 + 128;
                if (kfirst < 0) kfirst = 0;
                if (klast > T) klast = T;
                nlat = (klast - kfirst) >> 6; lat_row0 = b * T + kfirst; kpos0 = kfirst; qpos0 = start; masked = true;
            } else { nlat = 64; lat_row0 = b * T; }
        } else {
            const int u = id - n_lat;
            if (even) { hd = u & 7; b = u >> 3; }
            else { hd = u & 15; b = u >> 4; }
            qrow0 = NLAT + b * CL;
        }
        const int kvh = hd >> 2;
        float m_init = -1e30f, l0 = 0.f;
        if (even) { m_init = p.sink_logit[li * 8 + hd] * LOG2E; l0 = 1.0f; }
        attn_unit<VAR>(Q, ldq, hd * 64, qrow0, Kb, Vb, ldkv, kvh * 64, lat_row0, nlat, kpos0, qpos0, masked,
                  NLAT + b * CL, 4, m_init, l0, MIX, D, ocol0 + hd * 64, lds);
    }
    if (even) {
        const int n_pool = (NR / 128) * 4;
        for (int u = (int)((blockIdx.x + (gridDim.x >> 1)) % gridDim.x); u < n_pool; u += gridDim.x) pool_unit(p, li, (u >> 2) * 128, u & 3, lds);
    }
}

struct RowBuf { f32x4 x[4]; u32x2 xb[4]; u32x2 y[4]; };
template <bool HASY, bool FROM_IN>
DI void rowop_load(RowBuf& b, const float* __restrict__ xin, const bf16_t* __restrict__ xbin, const bf16_t* __restrict__ yin, int lane) {
    if (FROM_IN) {
#pragma unroll
        for (int i = 0; i < 4; ++i) b.x[i] = __builtin_nontemporal_load((const f32x4*)(xin + (i * 64 + lane) * 4));
    } else {
#pragma unroll
        for (int i = 0; i < 4; ++i) b.xb[i] = __builtin_nontemporal_load((const u32x2*)(xbin + (i * 64 + lane) * 4));
    }
    if (HASY) {
#pragma unroll
        for (int i = 0; i < 4; ++i) b.y[i] = __builtin_nontemporal_load((const u32x2*)(yin + (i * 64 + lane) * 4));
    }
}
template <int MODE, bool FROM_IN>
DI void rowop_run(const Params& p, int l, int row0, int nrows_run, int r, int lane, bool dry = false) {
    constexpr bool HASY = MODE != 0;
    const bool last = (MODE == 2 && l == 3);
    f32x4 pa[4], pb[4], pc[4];
    {
        const float* ad = p.ada + ((size_t)l * 17 + r) * 6 * D;
        int ln, so; const float* pre;
        if (MODE == 0) { ln = 0; so = 0; pre = p.mix_pre_g; }
        else if (MODE == 1) { ln = l; so = 3; pre = p.ffn_pre_g + l * D; }
        else { ln = (l < 3) ? l + 1 : l; so = 0; pre = p.mix_pre_g + ((l < 3) ? l + 1 : l) * D; }
        const float* ad2 = p.ada + ((size_t)ln * 17 + r) * 6 * D + so * D;
        const float* gate = ad + (MODE == 1 ? 2 : 5) * D;
        const float* pg = (MODE == 1 ? p.mix_post_g : p.ffn_post_g) + l * D;
#pragma unroll
        for (int i = 0; i < 4; ++i) {
            const int c = (i * 64 + lane) * 4;
            if (HASY) pa[i] = *(const f32x4*)(gate + c) * *(const f32x4*)(pg + c);
            pb[i] = *(const f32x4*)(pre + c) * (*(const f32x4*)(ad2 + D + c) + 1.0f);
            pc[i] = *(const f32x4*)(ad2 + c);
        }
    }
    auto xptr = [&](int row) -> const float* { return row < NLAT ? p.x + (size_t)row * D : p.ctx + (size_t)(row - NLAT) * D; };
    RowBuf cur, nxt;
    rowop_load<HASY, FROM_IN>(cur, xptr(row0), p.xres + (size_t)row0 * D, p.Y + (size_t)row0 * D, lane);
    for (int j = 0; j < nrows_run; ++j) {
        const int row = row0 + j;
        if (j + 1 < nrows_run) rowop_load<HASY, FROM_IN>(nxt, xptr(row + 1), p.xres + (size_t)(row + 1) * D, p.Y + (size_t)(row + 1) * D, lane);
        f32x4 xv[4];
#pragma unroll
        for (int i = 0; i < 4; ++i) {
            if (FROM_IN) xv[i] = cur.x[i];
            else { const u32x2 w = cur.xb[i]; xv[i][0] = bf2f(w.x & 0xffffu); xv[i][1] = bf2f(w.x >> 16); xv[i][2] = bf2f(w.y & 0xffffu); xv[i][3] = bf2f(w.y >> 16); }
        }
        if (HASY) {
            f32x4 yv[4]; float ss = 0.f;
#pragma unroll
            for (int i = 0; i < 4; ++i) {
                const u32x2 w = cur.y[i];
                yv[i][0] = bf2f(w.x & 0xffffu); yv[i][1] = bf2f(w.x >> 16); yv[i][2] = bf2f(w.y & 0xffffu); yv[i][3] = bf2f(w.y >> 16);
                ss += yv[i][0] * yv[i][0] + yv[i][1] * yv[i][1] + yv[i][2] * yv[i][2] + yv[i][3] * yv[i][3];
            }
#pragma unroll
            for (int o = 32; o >= 1; o >>= 1) ss += shx(ss, o, lane);
            const float rinv = rsqrtf(ss * (1.0f / D) + EPS);
#pragma unroll
            for (int i = 0; i < 4; ++i) xv[i] = xv[i] + pa[i] * (yv[i] * rinv);
            if (last) {
#pragma unroll
                for (int i = 0; i < 4; ++i) __builtin_nontemporal_store(xv[i], (f32x4*)(p.out + (size_t)row * D + (i * 64 + lane) * 4));
            } else if (!dry) {
#pragma unroll
                for (int i = 0; i < 4; ++i) { u32x2 w; w.x = pack2(xv[i][0], xv[i][1]); w.y = pack2(xv[i][2], xv[i][3]); __builtin_nontemporal_store(w, (u32x2*)(p.xres + (size_t)row * D + (i * 64 + lane) * 4)); }
            }
        }
        if (!last) {
            float ss = 0.f;
#pragma unroll
            for (int i = 0; i < 4; ++i) ss += xv[i][0] * xv[i][0] + xv[i][1] * xv[i][1] + xv[i][2] * xv[i][2] + xv[i][3] * xv[i][3];
#pragma unroll
            for (int o = 32; o >= 1; o >>= 1) ss += shx(ss, o, lane);
            const float rinv = rsqrtf(ss * (1.0f / D) + EPS);
#pragma unroll
            for (int i = 0; i < 4; ++i) {
                const f32x4 hv = xv[i] * rinv * pb[i] + pc[i];
                u32x2 w; w.x = pack2(hv[0], hv[1]); w.y = pack2(hv[2], hv[3]);
                *(u32x2*)(p.H + (size_t)row * D + (i * 64 + lane) * 4) = w;
            }
        }
        cur = nxt;
    }
}
template <int MODE, bool FROM_IN>
DI void phase_rowop_t(const Params& p, int l, bool dry = false) {
    const int lane = get_tid() & 63, wave = get_tid() >> 6;
    const int gw = blockIdx.x * NWAVE + wave, nw = gridDim.x * NWAVE;
    const bool lat_only = (MODE == 1 && l == 3) || (MODE == 2 && l == 3);
    for (int run = gw; run < NLAT / 32; run += nw) rowop_run<MODE, FROM_IN>(p, l, run * 32, 32, run >> 7, lane, dry);
    if (!lat_only) {
        for (int run = gw; run < NCTX / 2; run += nw) rowop_run<MODE, FROM_IN>(p, l, NLAT + run * 2, 2, 16, lane, dry);
    }
}
DI void phase_rowop(const Params& p, int l, int mode) {
    if (mode == 0) phase_rowop_t<0, true>(p, l);
    else if (mode == 1) { if (l == 0) phase_rowop_t<1, true>(p, l); else phase_rowop_t<1, false>(p, l); }
    else phase_rowop_t<2, false>(p, l);
}

DI void convert_tiles(const float* __restrict__ src, int K, int N, bf16_t* __restrict__ dst, int perm_mode, int& cursor, lchar* lds) {
    const int tk = K / 64, tn = N / 64, tid = get_tid(), hf = tid >> 8, t8 = tid & 255;
    LAS float* tile = (LAS float*)lds + hf * (64 * 65);
    const int ntl = tk * tn, G_ = (int)gridDim.x;
    const int tfirst = ((int)blockIdx.x - (cursor % G_) + G_) % G_;
    cursor += ntl;
    for (int base = tfirst; base < ntl; base += 2 * G_) {
        const int t = base + hf * G_;
        const bool valid = t < ntl;
        const int ki = t / tn, ni = t % tn;
        if (valid) {
            const int r = t8 >> 4, c4 = t8 & 15;
#pragma unroll
            for (int i = 0; i < 4; ++i) {
                const f32x4 v = __builtin_nontemporal_load((const f32x4*)(src + (size_t)(ki * 64 + r + 16 * i) * N + ni * 64 + c4 * 4));
                LAS float* d = tile + (r + 16 * i) * 65 + c4 * 4;
                d[0] = v[0]; d[1] = v[1]; d[2] = v[2]; d[3] = v[3];
            }
        }
        __syncthreads();
        if (valid) {
            const int n = t8 >> 2, kq = t8 & 3;
            int drow = ni * 64 + n;
            if (perm_mode == 1) drow = 256 * (ni >> 2) + 128 * (n >> 5) + 32 * (ni & 3) + (n & 31);
            else if (perm_mode == 2) drow = (ni < 42) ? (256 * (ni >> 1) + 64 * (ni & 1) + n) : (256 * ((ni - 42) >> 1) + 128 + 64 * ((ni - 42) & 1) + n);
            u32x4 w0, w1;
            const LAS float* s = tile + (kq * 16) * 65 + n;
            w0.x = pack2(s[0 * 65], s[1 * 65]); w0.y = pack2(s[2 * 65], s[3 * 65]); w0.z = pack2(s[4 * 65], s[5 * 65]); w0.w = pack2(s[6 * 65], s[7 * 65]);
            w1.x = pack2(s[8 * 65], s[9 * 65]); w1.y = pack2(s[10 * 65], s[11 * 65]); w1.z = pack2(s[12 * 65], s[13 * 65]); w1.w = pack2(s[14 * 65], s[15 * 65]);
            bf16_t* dp = dst + (size_t)drow * K + ki * 64 + kq * 16;
            *(u32x4*)(dp) = w0; *(u32x4*)(dp + 8) = w1;
        }
        __syncthreads();
    }
}

struct CvtDesc { const float* src; bf16_t* dst; int K, N, mode, ntl; };
DI CvtDesc cvt_desc(const Params& p, int mi) {
    const int l = mi >> 3, j = mi & 7, li = l >> 1; const bool even = (l & 1) == 0;
    CvtDesc d; d.mode = 0;
    if (j == 0) { d.K = D; d.mode = 1; d.dst = p.wt_in(l); if (even) { d.src = p.ab_w_in + (size_t)li * D * AB_IN; d.N = AB_IN; } else { d.src = p.c_w_qkv + (size_t)li * D * C_IN; d.N = C_IN; } }
    else if (j == 1) { d.K = D; d.N = D; d.dst = p.wt_out(l); d.src = (even ? p.ab_w_out : p.c_w_out) + (size_t)li * D * D; }
    else if (j == 2) { d.K = D; d.N = DFF2; d.mode = 2; d.dst = p.wt_up(l); d.src = p.ffn_w_up + (size_t)l * D * DFF2; }
    else if (j == 3) { d.K = DFF; d.N = D; d.dst = p.wt_down(l); d.src = p.ffn_w_down + (size_t)l * DFF * D; }
    else { const int g = j - 4; d.K = 128; d.N = 128; d.dst = p.wt_pool(li) + (size_t)g * 128 * 128; d.src = p.pool_w + ((size_t)li * 4 + g) * 128 * 128; }
    d.ntl = (j >= 4 && !even) ? 0 : (d.K / 64) * (d.N / 64);
    return d;
}
DI void convert_all(const Params& p, lchar* lds) {
    const int tid = get_tid(), hf = tid >> 8, t8 = tid & 255;
    LAS float* tl0 = (LAS float*)lds + hf * (2 * 64 * 65);
    constexpr int TOTAL = 2 * (320 + 256 + 16 + 1344 + 672) + 2 * (384 + 256 + 1344 + 672);
    const int stride = 2 * (int)gridDim.x, hb = (int)blockIdx.x * 2 + hf;
    int mi = 0, mbase = 0; CvtDesc d = cvt_desc(p, 0);
    const bool weighted = ((int)gridDim.x == 256);
    const bool upper = hb >= stride / 2;
    const int cyc = stride * 5 / 2;
    const int nk = weighted ? 3 * ((TOTAL + cyc - 1) / cyc) + 1 : (TOTAL + stride - 1) / stride;
    auto tile_of = [&](int k) -> int {
        if (!weighted) return hb + k * stride;
        if (!upper) { const int c = k >> 1, j = k & 1; return c * cyc + j * stride + hb; }
        const int c = k / 3, j = k - 3 * c;
        return c * cyc + (j < 2 ? j * stride + hb : 2 * stride + hb - stride / 2);
    };
    for (int k = 0; k < nk; k += 2) {
        f32x4 v[2][4]; bool valid[2]; int ki[2], ni[2], Kk[2], md[2]; bf16_t* dstp[2];
#pragma unroll
        for (int u = 0; u < 2; ++u) {
            const int g = tile_of(k + u);
            valid[u] = g < TOTAL;
            if (valid[u]) {
                while (g >= mbase + d.ntl) { mbase += d.ntl; ++mi; d = cvt_desc(p, mi); }
                const int t = g - mbase, tn = d.N >> 6;
                ki[u] = t / tn; ni[u] = t - ki[u] * tn; Kk[u] = d.K; md[u] = d.mode; dstp[u] = d.dst;
                const int r = t8 >> 4, c4 = t8 & 15;
#pragma unroll
                for (int i = 0; i < 4; ++i) v[u][i] = __builtin_nontemporal_load((const f32x4*)(d.src + (size_t)(ki[u] * 64 + r + 16 * i) * d.N + ni[u] * 64 + c4 * 4));
            }
        }
#pragma unroll
        for (int u = 0; u < 2; ++u)
            if (valid[u]) {
                const int r = t8 >> 4, c4 = t8 & 15;
#pragma unroll
                for (int i = 0; i < 4; ++i) { LAS float* dd = tl0 + u * (64 * 65) + (r + 16 * i) * 65 + c4 * 4; dd[0] = v[u][i][0]; dd[1] = v[u][i][1]; dd[2] = v[u][i][2]; dd[3] = v[u][i][3]; }
            }
        __syncthreads();
#pragma unroll
        for (int u = 0; u < 2; ++u)
            if (valid[u]) {
                const int n = t8 >> 2, kq = t8 & 3, nn = ni[u];
                int drow = nn * 64 + n;
                if (md[u] == 1) drow = 256 * (nn >> 2) + 128 * (n >> 5) + 32 * (nn & 3) + (n & 31);
                else if (md[u] == 2) drow = (nn < 42) ? (256 * (nn >> 1) + 64 * (nn & 1) + n) : (256 * ((nn - 42) >> 1) + 128 + 64 * ((nn - 42) & 1) + n);
                u32x4 w0, w1;
                const LAS float* s = tl0 + u * (64 * 65) + (kq * 16) * 65 + n;
                w0.x = pack2(s[0 * 65], s[1 * 65]); w0.y = pack2(s[2 * 65], s[3 * 65]); w0.z = pack2(s[4 * 65], s[5 * 65]); w0.w = pack2(s[6 * 65], s[7 * 65]);
                w1.x = pack2(s[8 * 65], s[9 * 65]); w1.y = pack2(s[10 * 65], s[11 * 65]); w1.z = pack2(s[12 * 65], s[13 * 65]); w1.w = pack2(s[14 * 65], s[15 * 65]);
                bf16_t* dp = dstp[u] + (size_t)drow * Kk[u] + ki[u] * 64 + kq * 16;
                *(u32x4*)(dp) = w0; *(u32x4*)(dp + 8) = w1;
            }
        __syncthreads();
    }
}

DI void phase_prologue(const Params& p, lchar* lds) {
    const int tid = get_tid();
    if ((int)blockIdx.x < 384) {
        LAS float* sl = (LAS float*)lds;
        LAS float* red = sl + 20 * 512;
        for (int item = blockIdx.x; item < 384; item += gridDim.x) {
            const int l = item / 96, n0 = (item % 96) * 64;
            const int col = tid & 63, kq = tid >> 6;
            float a[17];
#pragma unroll
            for (int r = 0; r < 17; ++r) a[r] = 0.f;
            for (int kh = 0; kh < 2; ++kh) {
                __syncthreads();
                for (int i = tid; i < 17 * 512; i += NTHR) {
                    const int r = i >> 9, kl = i & 511, k = kh * 512 + kl;
                    const float v = (r < 16) ? p.c[r * D + k] : p.c_ctx[k];
                    sl[kl * 20 + r] = v * sigmoidf_(v);
                }
                __syncthreads();
                const float* w = p.ada_w + ((size_t)l * D + kh * 512 + kq * 64) * 6144 + n0 + col;
                for (int k = 0; k < 64; ++k) {
                    const float wv = w[(size_t)k * 6144];
                    const LAS f32x4* sp = (const LAS f32x4*)(sl + (kq * 64 + k) * 20);
                    const f32x4 s0 = sp[0], s1 = sp[1], s2 = sp[2], s3 = sp[3]; const float s16 = sl[(kq * 64 + k) * 20 + 16];
#pragma unroll
                    for (int e = 0; e < 4; ++e) { a[e] += s0[e] * wv; a[4 + e] += s1[e] * wv; a[8 + e] += s2[e] * wv; a[12 + e] += s3[e] * wv; }
                    a[16] += s16 * wv;
                }
            }
#pragma unroll
            for (int r = 0; r < 17; ++r) red[(kq * 17 + r) * 64 + col] = a[r];
            __syncthreads();
            for (int i = tid; i < 17 * 64; i += NTHR) {
                const int r = i >> 6, cc = i & 63;
                float v = p.ada_b[l * 6144 + n0 + cc];
#pragma unroll
                for (int q8 = 0; q8 < 8; ++q8) v += red[(q8 * 17 + r) * 64 + cc];
                p.ada[((size_t)l * 17 + r) * 6144 + n0 + cc] = v;
            }
            __syncthreads();
        }
    }
    __syncthreads();
    convert_all(p, lds);
}

#define XB_TMO      128
#define XB_XCNT(j)  (256  + 64 * (j))
#define XB_XSUB(j)  (1280 + 64 * (j))
#define XB_XGEN(j)  (2304 + 64 * (j))
#define XB_TOP      3328
#define XB_TOPGEN   3392
#define XCD_BAR_WORDS 3456
#define XB_SPIN_CAP (1u << 18)

__device__ __forceinline__ unsigned xb_ld(unsigned* p)              { return __hip_atomic_load(p, __ATOMIC_RELAXED, __HIP_MEMORY_SCOPE_AGENT); }
__device__ __forceinline__ unsigned xb_add(unsigned* p, unsigned v) { return __hip_atomic_fetch_add(p, v, __ATOMIC_RELAXED, __HIP_MEMORY_SCOPE_AGENT); }
__device__ __forceinline__ unsigned xb_xcc_id() { return (unsigned)__builtin_amdgcn_s_getreg((3 << 11) | 20) & 0xFu; }
#define XB_SPIN(cond, bar) do { unsigned _sp = 0; while (cond) { __builtin_amdgcn_s_sleep(1); \
    if ((++_sp & 255u) == 0u) { if (xb_ld(&(bar)[XB_TMO])) break; if (_sp > XB_SPIN_CAP) { atomicAdd(&(bar)[XB_TMO], 1u); break; } } } } while (0)

struct XcdBarrier {
    unsigned* bar; unsigned x;
    volatile LAS unsigned* st;
};

__device__ __forceinline__ XcdBarrier xcd_barrier_post(unsigned* bar, volatile LAS unsigned* st) {
    XcdBarrier b; b.bar = bar; b.x = xb_xcc_id(); b.st = st;
    if (threadIdx.x == 0) (void)xb_add(&bar[XB_XCNT(b.x)], 1u);
    return b;
}
__device__ __forceinline__ void xcd_barrier_complete(unsigned* bar, unsigned x, unsigned& nloc, unsigned& nx) {
    const unsigned G = gridDim.x * gridDim.y * gridDim.z;
    unsigned sum, cnt, mine, sp = 0u;
    for (;;) {
        sum = 0u; cnt = 0u; mine = 0u;
#pragma unroll
        for (unsigned j = 0; j < 16; ++j) { const unsigned c = xb_ld(&bar[XB_XCNT(j)]); sum += c; cnt += (c > 0u) ? 1u : 0u; mine = (j == x) ? c : mine; }
        if (sum == G) break;
        __builtin_amdgcn_s_sleep(1);
        if ((++sp & 255u) == 0u) { if (xb_ld(&bar[XB_TMO])) break; if (sp > XB_SPIN_CAP) { atomicAdd(&bar[XB_TMO], 1u); break; } }
    }
    nloc = mine > 0u ? mine : 1u; nx = cnt > 0u ? cnt : 1u;
}

__device__ __forceinline__ void xcd_barrier(const XcdBarrier& b) {
    asm volatile("s_waitcnt vmcnt(0)" ::: "memory");
    __syncthreads();
    if (threadIdx.x == 0) {
        unsigned* bar = b.bar;
        __builtin_amdgcn_s_waitcnt(0);
        unsigned nloc = b.st[0], nx = b.st[1];
        if (nloc == 0u) { xcd_barrier_complete(bar, b.x, nloc, nx); b.st[0] = nloc; b.st[1] = nx; }
        const unsigned old = xb_add(&bar[XB_XSUB(b.x)], 1u);
        const unsigned gen = old / nloc;
        if (old + 1u == (gen + 1u) * nloc) {
            __builtin_amdgcn_fence(__ATOMIC_RELEASE, "agent");
            asm volatile("s_waitcnt vmcnt(0)" ::: "memory");
            const unsigned og = xb_add(&bar[XB_TOP], 1u);
            const unsigned tg = og / nx;
            if (og + 1u == (tg + 1u) * nx) xb_add(&bar[XB_TOPGEN], 1u);
            else XB_SPIN(xb_ld(&bar[XB_TOPGEN]) == tg, bar);
            __builtin_amdgcn_fence(__ATOMIC_ACQUIRE, "agent");
            xb_add(&bar[XB_XGEN(b.x)], 1u);
            asm volatile("s_waitcnt vmcnt(0)" ::: "memory");
        } else {
            XB_SPIN(xb_ld(&bar[XB_XGEN(b.x)]) == gen, bar);
            __builtin_amdgcn_fence(__ATOMIC_ACQUIRE, "agent");
            asm volatile("s_waitcnt vmcnt(0)" ::: "memory");
        }
    }
    __syncthreads();
}

DI void run_phase(const Params& p, int ph, lchar* lds) {
#ifdef ONLY
    if (ONLY == 0) { phase_prologue(p, lds); return; }
    if (ONLY == 1) { phase_rowop(p, ph & 3, ph % 3); return; }
    if (ONLY == 2) { phase_g1(p, ph & 3, lds); return; }
    if (ONLY == 3) { phase_mixer<0>(p, ph & 3, lds); return; }
    if (ONLY == 4) { phase_gy(p, p.PG, DFF, p.wt_down(ph & 3), NR / BM, lds); return; }
    if (ONLY == 5) { phase_g3(p, ph & 3, lds); return; }
    return;
#endif
    if (ph == 0) { phase_prologue(p, lds); if (PROBE_DUP == 5) { __syncthreads(); phase_prologue(p, lds); } return; }
    if (ph == 1) { phase_rowop(p, 0, 0); return; }
    const int q = ph - 2, l = q / 7, s = q % 7;
    const int reps = (((PROBE_DUP == 1 || PROBE_DUP >= 10) && s == 1 && (l & 1)) || (PROBE_DUP == 2 && (s == 0 || s == 2 || s == 4 || s == 5)) || (PROBE_DUP == 3 && s == 1 && !(l & 1)) || (PROBE_DUP == 4 && s == 4)) ? 2 : 1;
    for (int rep = 0; rep < reps; ++rep) {
        if (rep) __syncthreads();
        switch (s) {
            case 0: phase_g1(p, l, lds); break;
            case 1: if (PROBE_DUP >= 10 && rep == 0 && reps == 2) phase_mixer<(PROBE_DUP >= 10 ? PROBE_DUP - 10 : 0)>(p, l, lds); else phase_mixer<0>(p, l, lds); break;
            case 2: phase_gy(p, p.PG + (size_t)NR * 1536, D, p.wt_out(l), (l == 3) ? NLAT / BM : NR / BM, lds); break;
            case 3: phase_rowop(p, l, 1); break;
            case 4: phase_g3(p, l, lds); break;
            case 5: phase_gy(p, p.PG, DFF, p.wt_down(l), (l == 3) ? NLAT / BM : NR / BM, lds); break;
            default: phase_rowop(p, l, 2); break;
        }
    }
}

__global__ void __launch_bounds__(NTHR, 2) fwd_megakernel(Params p) {
    __shared__ __attribute__((aligned(16))) char smem[LDS_BYTES];
    __shared__ __attribute__((aligned(16))) unsigned xb_words[4];
    lchar* lds = (lchar*)smem;
    if (threadIdx.x < 4) xb_words[threadIdx.x] = 0u;
    __syncthreads();
    XcdBarrier xb = xcd_barrier_post(p.bar, (volatile LAS unsigned*)xb_words);
    for (int ph = p.ph_lo; ph < p.ph_hi; ++ph) {
        run_phase(p, ph, lds);
        if (ph + 1 < p.ph_hi) {
            if (p.ph_hi < 0) cg::this_grid().sync();
            xcd_barrier(xb);
            if (PROBE_DUP == 6) { xcd_barrier(xb); xcd_barrier(xb); }
        }
    }
}

extern "C" void kernel_launch(void* const* d_in, const int* in_sizes, int n_in, void* d_out, int out_size, void* d_ws, size_t ws_size,
                              hipStream_t stream) {
    static int grid_blocks = 0;
    if (!grid_blocks) {
        int dev = 0, cus = 0, per_cu = 0;
        hipGetDevice(&dev);
        hipDeviceGetAttribute(&cus, hipDeviceAttributeMultiprocessorCount, dev);
        hipOccupancyMaxActiveBlocksPerMultiprocessor(&per_cu, fwd_megakernel, NTHR, 0);
        per_cu = 1;
        grid_blocks = cus * per_cu;
    }
    Params p;
    memset(&p, 0, sizeof(p));
    const float* const* in = (const float* const*)d_in;
    p.x = in[0]; p.c = in[1]; p.ctx = in[2]; p.c_ctx = in[3]; p.ada_w = in[4]; p.ada_b = in[5];
    p.mix_pre_g = in[6]; p.mix_post_g = in[7]; p.ffn_pre_g = in[8]; p.ffn_post_g = in[9];
    p.ab_w_in = in[10]; p.ab_w_out = in[11]; p.pool_w = in[12]; p.pool_scale = in[13]; p.sink_logit = in[14];
    p.c_w_qkv = in[15]; p.c_w_out = in[16]; p.c_q_g = in[17]; p.c_k_g = in[18];
    p.ffn_w_up = in[19]; p.ffn_conv_w = in[20]; p.ffn_conv_b = in[21]; p.ffn_w_down = in[22];
    p.out = (float*)d_out;
    char* w = (char*)d_ws; size_t off = 0;
    auto take = [&](size_t bytes) { char* r = w + off; off += (bytes + 255) & ~(size_t)255; return r; };
    p.xres = (bf16_t*)take((size_t)NR * D * 2);
    p.H = (bf16_t*)take((size_t)NR * D * 2);
    p.Y = (bf16_t*)take((size_t)NR * D * 2);
    p.PG = (bf16_t*)take((size_t)NR * DFF * 2);
    p.ada = (float*)take((size_t)4 * 17 * 6144 * 4);
    p.bar = (unsigned*)take((size_t)XCD_BAR_WORDS * 4);
    p.wt_in_b = (bf16_t*)take((size_t)4 * C_IN * D * 2);
    p.wt_out_b = (bf16_t*)take((size_t)4 * D * D * 2);
    p.wt_up_b = (bf16_t*)take((size_t)4 * DFF2 * D * 2);
    p.wt_down_b = (bf16_t*)take((size_t)4 * D * DFF * 2);
    p.wt_pool_b = (bf16_t*)take((size_t)2 * 4 * 128 * 128 * 2);
    if (off > ws_size) { fprintf(stderr, "workspace too small: need %zu have %zu\n", off, ws_size); return; }
#if MULTI_LAUNCH
    for (int ph = 0; ph < NPHASE; ++ph) {
        p.ph_lo = ph; p.ph_hi = ph + 1;
        hipLaunchKernelGGL(fwd_megakernel, dim3(grid_blocks), dim3(NTHR), 0, stream, p);
    }
#else
    p.ph_lo = 0; p.ph_hi = NPHASE;
    hipMemsetAsync(p.bar, 0, (size_t)XCD_BAR_WORDS * 4, stream);
    void* args[] = {&p};
    hipError_t e = hipLaunchCooperativeKernel((void*)fwd_megakernel, dim3(grid_blocks), dim3(NTHR), args, 0, stream);
    if (e != hipSuccess) fprintf(stderr, "cooperative launch failed: %s (grid %d)\n", hipGetErrorString(e), grid_blocks);
#endif
}
```

```cpp
#include <hip/hip_runtime.h>
#include <hip/hip_cooperative_groups.h>
#include <cstdio>
#include <cstdint>
#include <cstring>
namespace cg = cooperative_groups;

#ifndef MULTI_LAUNCH
#define MULTI_LAUNCH 0
#define PROBE_DUP 0
#endif

#ifndef PROBE_DUP
#define PROBE_DUP 0
#endif
#define DI __device__ __forceinline__
#define LAS __attribute__((address_space(3)))
typedef unsigned short bf16_t;
typedef short bf16x8 __attribute__((ext_vector_type(8)));
typedef short s16x4 __attribute__((ext_vector_type(4)));
typedef float f32x16 __attribute__((ext_vector_type(16)));
typedef float f32x4 __attribute__((ext_vector_type(4)));
typedef float f32x2 __attribute__((ext_vector_type(2)));
typedef __bf16 bf16x2_t __attribute__((ext_vector_type(2)));
typedef unsigned u32x2 __attribute__((ext_vector_type(2)));
typedef unsigned u32x4 __attribute__((ext_vector_type(4)));
typedef LAS char lchar;

__device__ __attribute__((aligned(16))) const float ROPE_COS[1024] = {1.00000000e+00f,1.00000000e+00f,1.00000000e+00f,1.00000000e+00f,1.00000000e+00f,1.00000000e+00f,1.00000000e+00f,1.00000000e+00f,1.00000000e+00f,1.00000000e+00f,1.00000000e+00f,1.00000000e+00f,1.00000000e+00f,1.00000000e+00f,1.00000000e+00f,1.00000000e+00f,5.40302277e-01f,8.46009135e-01f,9.50415254e-01f,9.84230220e-01f,9.95004177e-01f,9.98419285e-01f,9.99500036e-01f,9.99841869e-01f,9.99949992e-01f,9.99984205e-01f,9.99994993e-01f,9.99998391e-01f,9.99999523e-01f,9.99999821e-01f,9.99999940e-01f,1.00000000e+00f,-4.16146845e-01f,4.31462824e-01f,8.06578398e-01f,9.37418282e-01f,9.80066597e-01f,9.93682086e-01f,9.98000681e-01f,9.99367595e-01f,9.99800026e-01f,9.99936759e-01f,9.99979973e-01f,9.99993682e-01f,9.99997973e-01f,9.99999344e-01f,9.99999821e-01f,9.99999940e-01f,-9.89992499e-01f,-1.15966164e-01f,5.82753658e-01f,8.61040652e-01f,9.55336511e-01f,9.85803485e-01f,9.95503366e-01f,9.98577297e-01f,9.99550045e-01f,9.99857724e-01f,9.99954998e-01f,9.99985754e-01f,9.99995530e-01f,9.99998569e-01f,9.99999523e-01f,9.99999881e-01f,-6.53643608e-01f,-6.27679706e-01f,3.01137477e-01f,7.57506192e-01f,9.21060979e-01f,9.74808276e-01f,9.92010653e-01f,9.97471273e-01f,9.99200106e-01f,9.99747038e-01f,9.99920011e-01f,9.99974728e-01f,9.99992013e-01f,9.99997497e-01f,9.99999225e-01f,9.99999762e-01f,2.83662200e-01f,-9.46079254e-01f,-1.03423381e-02f,6.30080283e-01f,8.77582550e-01f,9.60731268e-01f,9.87526000e-01f,9.96049762e-01f,9.98750269e-01f,9.99604762e-01f,9.99875009e-01f,9.99960482e-01f,9.99987483e-01f,9.99996066e-01f,9.99998748e-01f,9.99999583e-01f,9.60170269e-01f,-9.73103702e-01f,-3.20796400e-01f,4.82782036e-01f,8.25335622e-01f,9.43616986e-01f,9.82053936e-01f,9.94313300e-01f,9.98200536e-01f,9.99430835e-01f,9.99819994e-01f,9.99943078e-01f,9.99981999e-01f,9.99994338e-01f,9.99998212e-01f,9.99999404e-01f,7.53902256e-01f,-7.00429797e-01f,-5.99437475e-01f,3.20257008e-01f,7.64842212e-01f,9.23519433e-01f,9.75599885e-01f,9.92262423e-01f,9.97551024e-01f,9.99225318e-01f,9.99755025e-01f,9.99922514e-01f,9.99975502e-01f,9.99992251e-01f,9.99997556e-01f,9.99999225e-01f,-1.45500034e-01f,-2.12036446e-01f,-8.18632424e-01f,1.47631213e-01f,6.96706712e-01f,9.00502324e-01f,9.68170285e-01f,9.89897788e-01f,9.96801734e-01f,9.98988271e-01f,9.99680042e-01f,9.99898791e-01f,9.99967992e-01f,9.99989867e-01f,9.99996781e-01f,9.99998987e-01f,-9.11130250e-01f,3.41660261e-01f,-9.56644177e-01f,-2.96507962e-02f,6.21609926e-01f,8.74638259e-01f,9.59772646e-01f,9.87220109e-01f,9.95952725e-01f,9.98719573e-01f,9.99595046e-01f,9.99871910e-01f,9.99959528e-01f,9.99987185e-01f,9.99995947e-01f,9.99998748e-01f,-8.39071512e-01f,7.90131867e-01f,-9.99786079e-01f,-2.05997631e-01f,5.40302277e-01f,8.46009135e-01f,9.50415313e-01f,9.84230220e-01f,9.95004177e-01f,9.98419285e-01f,9.99500036e-01f,9.99841869e-01f,9.99949992e-01f,9.99984205e-01f,9.99994993e-01f,9.99998391e-01f,4.42569796e-03f,9.95257378e-01f,-9.43779767e-01f,-3.75847399e-01f,4.53596085e-01f,8.14705312e-01f,9.40107584e-01f,9.80929136e-01f,9.93956089e-01f,9.98087406e-01f,9.99395072e-01f,9.99808669e-01f,9.99939501e-01f,9.99980867e-01f,9.99993920e-01f,9.99998093e-01f,8.43853951e-01f,8.93861592e-01f,-7.94179380e-01f,-5.33843040e-01f,3.62357706e-01f,7.80825913e-01f,9.28859890e-01f,9.77317870e-01f,9.92808640e-01f,9.97723997e-01f,9.99280095e-01f,9.99772310e-01f,9.99927998e-01f,9.99977231e-01f,9.99992788e-01f,9.99997735e-01f,9.07446802e-01f,5.17172873e-01f,-5.65820515e-01f,-6.75001681e-01f,2.67498761e-01f,7.44477987e-01f,9.16683376e-01f,9.73397553e-01f,9.91561890e-01f,9.97329056e-01f,9.99155104e-01f,9.99732792e-01f,9.99915481e-01f,9.99973297e-01f,9.99991536e-01f,9.99997318e-01f,1.36737213e-01f,-1.87961515e-02f,-2.81349480e-01f,-7.94870913e-01f,1.69967160e-01f,7.05776393e-01f,9.03590262e-01f,9.69169438e-01f,9.90216017e-01f,9.96902585e-01f,9.99020159e-01f,9.99690115e-01f,9.99902010e-01f,9.99969006e-01f,9.99990225e-01f,9.99996901e-01f,-7.59687901e-01f,-5.48975468e-01f,3.10223512e-02f,-8.89670432e-01f,7.07371980e-02f,6.64843500e-01f,8.89593601e-01f,9.64634836e-01f,9.88771081e-01f,9.96444523e-01f,9.98875201e-01f,9.99644279e-01f,9.99887526e-01f,9.99964416e-01f,9.99988735e-01f,9.99996424e-01f,-9.57659483e-01f,-9.10081089e-01f,3.40318173e-01f,-9.56410050e-01f,-2.91995462e-02f,6.21808827e-01f,8.74707460e-01f,9.59795177e-01f,9.87227261e-01f,9.95954990e-01f,9.98720288e-01f,9.99595284e-01f,9.99872029e-01f,9.99959528e-01f,9.99987185e-01f,9.99995947e-01f,-2.75163352e-01f,-9.90897954e-01f,6.15864813e-01f,-9.92985010e-01f,-1.28844544e-01f,5.76808274e-01f,8.58946681e-01f,9.54652011e-01f,9.85584795e-01f,9.95433986e-01f,9.98555362e-01f,9.99543071e-01f,9.99855518e-01f,9.99954283e-01f,9.99985576e-01f,9.99995410e-01f,6.60316706e-01f,-7.66536534e-01f,8.30336154e-01f,-9.98241663e-01f,-2.27202162e-01f,5.29984176e-01f,8.42327058e-01f,9.49207008e-01f,9.83843684e-01f,9.94881511e-01f,9.98380423e-01f,9.99487758e-01f,9.99837995e-01f,9.99948800e-01f,9.99983788e-01f,9.99994874e-01f,9.88704622e-01f,-3.06095392e-01f,9.62463796e-01f,-9.72014248e-01f,-3.23289543e-01f,4.81484592e-01f,8.24865162e-01f,9.43461835e-01f,9.82004225e-01f,9.94297504e-01f,9.98195529e-01f,9.99429286e-01f,9.99819517e-01f,9.99942899e-01f,9.99981940e-01f,9.99994278e-01f,4.08082068e-01f,2.48616725e-01f,9.99144375e-01f,-9.15129960e-01f,-4.16146845e-01f,4.31462824e-01f,8.06578457e-01f,9.37418282e-01f,9.80066597e-01f,9.93682086e-01f,9.98000681e-01f,9.99367595e-01f,9.99800026e-01f,9.99936759e-01f,9.99979973e-01f,9.99993682e-01f,-5.47729254e-01f,7.26760268e-01f,9.36740458e-01f,-8.29382956e-01f,-5.04846215e-01f,3.80077004e-01f,7.87485182e-01f,9.31078374e-01f,9.78030920e-01f,9.93035257e-01f,9.97795820e-01f,9.99302804e-01f,9.99779522e-01f,9.99930263e-01f,9.99977946e-01f,9.99993026e-01f,-9.99960840e-01f,9.81074572e-01f,7.81440377e-01f,-7.17477441e-01f,-5.88501155e-01f,3.27489585e-01f,7.67604589e-01f,9.24443960e-01f,9.75897431e-01f,9.92357016e-01f,9.97581005e-01f,9.99234855e-01f,9.99758005e-01f,9.99923468e-01f,9.99975801e-01f,9.99992371e-01f,-5.32833040e-01f,9.33235765e-01f,5.48645258e-01f,-5.82943261e-01f,-6.66275978e-01f,2.73866832e-01f,7.46956408e-01f,9.17517304e-01f,9.73666370e-01f,9.91647422e-01f,9.97356176e-01f,9.99163687e-01f,9.99735534e-01f,9.99916375e-01f,9.99973536e-01f,9.99991655e-01f,4.24179018e-01f,5.97977161e-01f,2.61441678e-01f,-4.30023283e-01f,-7.37393796e-01f,2.19378278e-01f,7.25561321e-01f,9.10300434e-01f,9.71337974e-01f,9.90906477e-01f,9.97121394e-01f,9.99089420e-01f,9.99711990e-01f,9.99908924e-01f,9.99971211e-01f,9.99990880e-01f,9.91202831e-01f,7.85522610e-02f,-5.16893305e-02f,-2.63540596e-01f,-8.01143587e-01f,1.64196163e-01f,7.03440726e-01f,9.02795732e-01f,9.68912423e-01f,9.90134120e-01f,9.96876657e-01f,9.99011934e-01f,9.99687493e-01f,9.99901175e-01f,9.99968767e-01f,9.99990106e-01f,6.46919310e-01f,-4.65064496e-01f,-3.59694332e-01f,-8.87455046e-02f,-8.56888831e-01f,1.08494945e-01f,6.80616796e-01f,8.95005584e-01f,9.66389954e-01f,9.89330530e-01f,9.96621907e-01f,9.98931348e-01f,9.99662042e-01f,9.99893129e-01f,9.99966204e-01f,9.99989331e-01f,-2.92138815e-01f,-8.65450621e-01f,-6.32028639e-01f,8.88481140e-02f,-9.04072165e-01f,5.24506159e-02f,6.57112300e-01f,8.86932373e-01f,9.63770926e-01f,9.88495648e-01f,9.96357203e-01f,9.98847544e-01f,9.99635518e-01f,9.99884725e-01f,9.99963522e-01f,9.99988496e-01f,-9.62605894e-01f,-9.99293387e-01f,-8.41684937e-01f,2.63639510e-01f,-9.42222297e-01f,-3.75941908e-03f,6.32950664e-01f,8.78578722e-01f,9.61055458e-01f,9.87629473e-01f,9.96082544e-01f,9.98760641e-01f,9.99608040e-01f,9.99876022e-01f,9.99960780e-01f,9.99987602e-01f,-7.48057544e-01f,-8.25371623e-01f,-9.67871487e-01f,4.30115849e-01f,-9.70958173e-01f,-5.99575676e-02f,6.08156204e-01f,8.69947195e-01f,9.58243906e-01f,9.86732066e-01f,9.95797932e-01f,9.98670578e-01f,9.99579549e-01f,9.99867022e-01f,9.99957979e-01f,9.99986708e-01f,1.54251456e-01f,-3.97251874e-01f,-9.98075247e-01f,5.83026946e-01f,-9.89992499e-01f,-1.15966164e-01f,5.82753658e-01f,8.61040652e-01f,9.55336511e-01f,9.85803485e-01f,9.95503366e-01f,9.98577297e-01f,9.99550045e-01f,9.99857724e-01f,9.99954998e-01f,9.99985754e-01f,9.14742351e-01f,1.53215483e-01f,-9.29300308e-01f,7.17549205e-01f,-9.99135137e-01f,-1.71608135e-01f,5.56768358e-01f,8.51861775e-01f,9.52333570e-01f,9.84843671e-01f,9.95198846e-01f,9.98480916e-01f,9.99519527e-01f,9.99848068e-01f,9.99951959e-01f,9.99984801e-01f,8.34223390e-01f,6.56495154e-01f,-7.68367112e-01f,8.29440355e-01f,-9.98294771e-01f,-2.26707578e-01f,5.30226350e-01f,8.42413545e-01f,9.49235439e-01f,9.83852804e-01f,9.94884372e-01f,9.98381376e-01f,9.99488056e-01f,9.99838114e-01f,9.99948800e-01f,9.99983788e-01f,-1.32767474e-02f,9.57586050e-01f,-5.31235278e-01f,9.15171385e-01f,-9.87479806e-01f,-2.81090319e-01f,5.03154159e-01f,8.32698941e-01f,9.46042359e-01f,9.82830763e-01f,9.94559944e-01f,9.98278618e-01f,9.99455571e-01f,9.99827802e-01f,9.99945521e-01f,9.99982774e-01f,-8.48570287e-01f,9.63757515e-01f,-2.41421118e-01f,9.72038329e-01f,-9.66798186e-01f,-3.34584385e-01f,4.75578904e-01f,8.22721004e-01f,9.42754686e-01f,9.81777668e-01f,9.94225562e-01f,9.98172760e-01f,9.99422073e-01f,9.99817252e-01f,9.99942183e-01f,9.99981701e-01f,-9.03692186e-01f,6.73110247e-01f,7.23346695e-02f,9.98247743e-01f,-9.36456680e-01f,-3.87020677e-01f,4.47528064e-01f,8.12482953e-01f,9.39372718e-01f,9.80693519e-01f,9.93881226e-01f,9.98063743e-01f,9.99387562e-01f,9.99806345e-01f,9.99938726e-01f,9.99980628e-01f,-1.27963692e-01f,1.75156534e-01f,3.78916174e-01f,9.92972851e-01f,-8.96758378e-01f,-4.38233554e-01f,4.19029742e-01f,8.01987886e-01f,9.35896814e-01f,9.79578316e-01f,9.93526995e-01f,9.97951567e-01f,9.99352098e-01f,9.99795079e-01f,9.99935210e-01f,9.99979496e-01f,7.65414059e-01f,-3.76742303e-01f,6.47921681e-01f,9.56380010e-01f,-8.48100007e-01f,-4.88060862e-01f,3.90112430e-01f,7.91239262e-01f,9.32327330e-01f,9.78432178e-01f,9.93162811e-01f,9.97836173e-01f,9.99315560e-01f,9.99783576e-01f,9.99931574e-01f,9.99978364e-01f,9.55073655e-01f,-8.12611222e-01f,8.52673113e-01f,8.89623463e-01f,-7.90967762e-01f,-5.36345184e-01f,3.60805035e-01f,7.80240417e-01f,9.28664625e-01f,9.77255106e-01f,9.92788672e-01f,9.97717679e-01f,9.99278069e-01f,9.99771714e-01f,9.99927819e-01f,9.99977171e-01f,2.66642928e-01f,-9.98210371e-01f,9.72865343e-01f,7.94808388e-01f,-7.25932240e-01f,-5.82933903e-01f,3.31136853e-01f,7.68994927e-01f,9.24909055e-01f,9.76047099e-01f,9.92404640e-01f,9.97596025e-01f,9.99239624e-01f,9.99759495e-01f,9.99923944e-01f,9.99975979e-01f,-6.66938066e-01f,-8.76379430e-01f,9.96578991e-01f,6.74925625e-01f,-6.53643608e-01f,-6.27679706e-01f,3.01137596e-01f,7.57506192e-01f,9.21060979e-01f,9.74808276e-01f,9.92010653e-01f,9.97471273e-01f,9.99200106e-01f,9.99747038e-01f,9.99920011e-01f,9.99974728e-01f,-9.87339258e-01f,-4.84639406e-01f,9.21462357e-01f,5.33756077e-01f,-5.74824035e-01f,-6.70441091e-01f,2.70837069e-01f,7.45777905e-01f,9.17120814e-01f,9.73538578e-01f,9.91606772e-01f,9.97343302e-01f,9.99159634e-01f,9.99734223e-01f,9.99915957e-01f,9.99973416e-01f,-3.99985313e-01f,5.63609414e-02f,7.54965365e-01f,3.75752151e-01f,-4.90260571e-01f,-7.11082935e-01f,2.40265876e-01f,7.33813822e-01f,9.13088918e-01f,9.72238123e-01f,9.91192937e-01f,9.97212172e-01f,9.99118149e-01f,9.99721110e-01f,9.99911785e-01f,9.99972105e-01f,5.55113316e-01f,5.80003142e-01f,5.13598442e-01f,2.05897167e-01f,-4.00799006e-01f,-7.49476731e-01f,2.09454417e-01f,7.21617639e-01f,9.08965766e-01f,9.70906913e-01f,9.90769207e-01f,9.97077882e-01f,9.99075651e-01f,9.99707639e-01f,9.99907553e-01f,9.99970794e-01f,9.99843299e-01f,9.25014675e-01f,2.21298173e-01f,2.95478199e-02f,-3.07332784e-01f,-7.85501122e-01f,1.78433523e-01f,7.09193349e-01f,9.04751658e-01f,9.69545007e-01f,9.90335584e-01f,9.96940494e-01f,9.99032140e-01f,9.99693930e-01f,9.99903202e-01f,9.99969363e-01f,5.25321960e-01f,9.85138178e-01f,-9.29481089e-02f,-1.47732988e-01f,-2.10795805e-01f,-8.19042206e-01f,1.47234216e-01f,6.96544766e-01f,9.00447130e-01f,9.68152404e-01f,9.89892066e-01f,9.96799886e-01f,9.98987675e-01f,9.99679863e-01f,9.99898732e-01f,9.99967992e-01f,-4.32177931e-01f,7.41858006e-01f,-3.97976756e-01f,-3.20354372e-01f,-1.12152621e-01f,-8.49993885e-01f,1.15887694e-01f,6.83675885e-01f,8.96052480e-01f,9.66729224e-01f,9.89438653e-01f,9.96656179e-01f,9.98942196e-01f,9.99665439e-01f,9.99894202e-01f,9.99966562e-01f,-9.92335498e-01f,2.70098448e-01f,-6.63538277e-01f,-4.82871950e-01f,-1.23883775e-02f,-8.78258407e-01f,8.44252855e-02f,6.70590878e-01f,8.91568303e-01f,9.65275466e-01f,9.88975346e-01f,9.96509314e-01f,9.98895705e-01f,9.99650776e-01f,9.99889553e-01f,9.99965072e-01f,-6.40144348e-01f,-2.84846604e-01f,-8.63296509e-01f,-6.30159974e-01f,8.74991715e-02f,-9.03746367e-01f,5.28784581e-02f,6.57293737e-01f,8.86994898e-01f,9.63791192e-01f,9.88502085e-01f,9.96359289e-01f,9.98848200e-01f,9.99635756e-01f,9.99884784e-01f,9.99963582e-01f,3.00592542e-01f,-7.52063990e-01f,-9.77442741e-01f,-7.57573068e-01f,1.86512470e-01f,-9.26377118e-01f,2.12787576e-02f,6.43788815e-01f,8.82332861e-01f,9.62276459e-01f,9.88018990e-01f,9.96206105e-01f,9.98799741e-01f,9.99620378e-01f,9.99879956e-01f,9.99962032e-01f,9.64965999e-01f,-9.87659097e-01f,-9.94656444e-01f,-8.61092687e-01f,2.83662200e-01f,-9.46079254e-01f,-1.03422189e-02f,6.30080283e-01f,8.77582550e-01f,9.60731268e-01f,9.87526000e-01f,9.96049762e-01f,9.98750269e-01f,9.99604762e-01f,9.99875009e-01f,9.99960482e-01f,7.42154181e-01f,-9.19073522e-01f,-9.13230121e-01f,-9.37454224e-01f,3.77977669e-01f,-9.62790370e-01f,-4.19528559e-02f,6.16172493e-01f,8.72744501e-01f,9.59155679e-01f,9.87023175e-01f,9.95890260e-01f,9.98699784e-01f,9.99588788e-01f,9.99869943e-01f,9.99958873e-01f,-1.62990779e-01f,-5.67430019e-01f,-7.41239965e-01f,-9.84248459e-01f,4.68516916e-01f,-9.76457715e-01f,-7.35215396e-02f,6.02069914e-01f,8.67819190e-01f,9.57549810e-01f,9.86510456e-01f,9.95727658e-01f,9.98648286e-01f,9.99572515e-01f,9.99864817e-01f,9.99957263e-01f,-9.18282807e-01f,-4.10281904e-02f,-4.95741814e-01f,-1.00000000e+00f,5.54374516e-01f,-9.87038016e-01f,-1.05016708e-01f,5.87776959e-01f,8.62807095e-01f,9.55913603e-01f,9.85987842e-01f,9.95561838e-01f,9.98595834e-01f,9.99555886e-01f,9.99859571e-01f,9.99955595e-01f,-8.29309821e-01f,4.98009592e-01f,-2.01079622e-01f,-9.84212041e-01f,6.34692967e-01f,-9.94497895e-01f,-1.36406869e-01f,5.73298037e-01f,8.57708693e-01f,9.54247177e-01f,9.85455394e-01f,9.95392919e-01f,9.98542368e-01f,9.99538958e-01f,9.99854207e-01f,9.99953866e-01f,2.21267566e-02f,8.83669317e-01f,1.13521777e-01f,-9.37382519e-01f,7.08669782e-01f,-9.98813629e-01f,-1.67660639e-01f,5.58637917e-01f,8.52524519e-01f,9.52550590e-01f,9.84913111e-01f,9.95220840e-01f,9.98487890e-01f,9.99521732e-01f,9.99848783e-01f,9.99952197e-01f,8.53220105e-01f,9.97174621e-01f,4.16867077e-01f,-8.60988438e-01f,7.75565803e-01f,-9.99971747e-01f,-1.98746875e-01f,5.43801069e-01f,8.47255111e-01f,9.50823903e-01f,9.84360933e-01f,9.95045662e-01f,9.98432398e-01f,9.99504209e-01f,9.99843180e-01f,9.99950409e-01f,8.99866819e-01f,8.03569078e-01f,6.78870201e-01f,-7.57439196e-01f,8.34712923e-01f,-9.97968495e-01f,-2.29634270e-01f,5.28792322e-01f,8.41901004e-01f,9.49067116e-01f,9.83798921e-01f,9.94867265e-01f,9.98375952e-01f,9.99486327e-01f,9.99837577e-01f,9.99948621e-01f,1.19180135e-01f,3.62476677e-01f,8.73550534e-01f,-6.30000710e-01f,8.85519624e-01f,-9.92810190e-01f,-2.60292053e-01f,5.13616323e-01f,8.36462677e-01f,9.47280347e-01f,9.83227074e-01f,9.94685769e-01f,9.98318493e-01f,9.99468148e-01f,9.99831796e-01f,9.99946833e-01f,-7.71080196e-01f,-1.90249100e-01f,9.81602073e-01f,-4.82692331e-01f,9.27478492e-01f,-9.84513164e-01f,-2.90689558e-01f,4.98277903e-01f,8.30940723e-01f,9.45463598e-01f,9.82645452e-01f,9.94501114e-01f,9.98260021e-01f,9.99449670e-01f,9.99825954e-01f,9.99944985e-01f,-9.52412963e-01f,-6.84381902e-01f,9.92308319e-01f,-3.20159167e-01f,9.60170269e-01f,-9.73103702e-01f,-3.20796400e-01f,4.82782036e-01f,8.25335622e-01f,9.43616986e-01f,9.82053936e-01f,9.94313300e-01f,9.98200536e-01f,9.99430835e-01f,9.99819994e-01f,9.99943078e-01f,-2.58101642e-01f,-9.67739642e-01f,9.04607594e-01f,-1.47529200e-01f,9.83268440e-01f,-9.58617806e-01f,-3.50582451e-01f,4.67133403e-01f,8.19648027e-01f,9.41740453e-01f,9.81452644e-01f,9.94122326e-01f,9.98140097e-01f,9.99411702e-01f,9.99813974e-01f,9.99941170e-01f,6.73507154e-01f,-9.53050017e-01f,7.27198064e-01f,2.97537707e-02f,9.96542096e-01f,-9.41101313e-01f,-3.80017966e-01f,4.51337039e-01f,8.13878477e-01f,9.39834237e-01f,9.80841517e-01f,9.93928254e-01f,9.98078644e-01f,9.99392271e-01f,9.99807835e-01f,9.99939203e-01f,9.85896587e-01f,-6.44837022e-01f,4.77671444e-01f,2.06098333e-01f,9.99858618e-01f,-9.20609534e-01f,-4.09073502e-01f,4.35397953e-01f,8.08027506e-01f,9.37898219e-01f,9.80220556e-01f,9.93731022e-01f,9.98016179e-01f,9.99372482e-01f,9.99801576e-01f,9.99937236e-01f};
__device__ __attribute__((aligned(16))) const float ROPE_SIN[1024] = {0.00000000e+00f,0.00000000e+00f,0.00000000e+00f,0.00000000e+00f,0.00000000e+00f,0.00000000e+00f,0.00000000e+00f,0.00000000e+00f,0.00000000e+00f,0.00000000e+00f,0.00000000e+00f,0.00000000e+00f,0.00000000e+00f,0.00000000e+00f,0.00000000e+00f,0.00000000e+00f,8.41470957e-01f,5.33168435e-01f,3.10983598e-01f,1.76892191e-01f,9.98334214e-02f,5.62044978e-02f,3.16175036e-02f,1.77818574e-02f,9.99983307e-03f,5.62338345e-03f,3.16227227e-03f,1.77827850e-03f,9.99999931e-04f,5.62341243e-04f,3.16227757e-04f,1.77827940e-04f,9.09297407e-01f,9.02130723e-01f,5.91127098e-01f,3.48205268e-01f,1.98669329e-01f,1.12231314e-01f,6.32033944e-02f,3.55580896e-02f,1.99986659e-02f,1.12465890e-02f,6.32451288e-03f,3.55655141e-03f,1.99999870e-03f,1.12468237e-03f,6.32455456e-04f,3.55655880e-04f,1.41120002e-01f,9.93253171e-01f,8.12648892e-01f,5.08536100e-01f,2.95520216e-01f,1.67903304e-01f,9.47260857e-02f,5.33230826e-02f,2.99954992e-02f,1.68694388e-02f,9.48669016e-03f,5.33481315e-03f,2.99999560e-03f,1.68702309e-03f,9.48683126e-04f,5.33483806e-04f,-7.56802499e-01f,7.78471708e-01f,9.53580737e-01f,6.52827978e-01f,3.89418334e-01f,2.23044485e-01f,1.26154065e-01f,7.10712075e-02f,3.99893336e-02f,2.24917568e-02f,1.26487734e-02f,7.11305765e-03f,3.99998948e-03f,2.24936334e-03f,1.26491068e-03f,7.11311703e-04f,-9.58924294e-01f,3.23935270e-01f,9.99946535e-01f,7.76529968e-01f,4.79425550e-01f,2.77480543e-01f,1.57455876e-01f,8.87968615e-02f,4.99791652e-02f,2.81133614e-02f,1.58107281e-02f,8.89127981e-03f,4.99997940e-03f,2.81170290e-03f,1.58113812e-03f,8.89139599e-04f,-2.79415488e-01f,-2.30367512e-01f,9.47148204e-01f,8.75740528e-01f,5.64642489e-01f,3.31039310e-01f,1.88600272e-01f,1.06494442e-01f,5.99640049e-02f,3.37340795e-02f,1.89725272e-02f,1.06694745e-02f,5.99996420e-03f,3.37404152e-03f,1.89736532e-03f,1.06696738e-03f,6.56986594e-01f,-7.13721275e-01f,8.00421596e-01f,9.47330713e-01f,6.44217670e-01f,3.83551568e-01f,2.19556093e-01f,1.24158338e-01f,6.99428469e-02f,3.93537246e-02f,2.21341345e-02f,1.24476347e-02f,6.99994294e-03f,3.93637875e-03f,2.21359241e-03f,1.24479528e-03f,9.89358246e-01f,-9.77261782e-01f,5.74317753e-01f,9.89042461e-01f,7.17356086e-01f,4.34851229e-01f,2.50292331e-01f,1.41782969e-01f,7.99146891e-02f,4.49721329e-02f,2.52955221e-02f,1.42257558e-02f,7.99991470e-03f,4.49871505e-03f,2.52981926e-03f,1.42262306e-03f,4.12118495e-01f,-9.39823508e-01f,2.91259229e-01f,9.99560297e-01f,7.83326924e-01f,4.84776139e-01f,2.80778319e-01f,1.59362778e-01f,8.98785442e-02f,5.05891182e-02f,2.84566563e-02f,1.60038304e-02f,8.99987947e-03f,5.06105041e-03f,2.84604589e-03f,1.60045072e-03f,-5.44021130e-01f,-6.12936914e-01f,-2.06835698e-02f,9.78552461e-01f,8.41470957e-01f,5.33168435e-01f,3.10983568e-01f,1.76892191e-01f,9.98334140e-02f,5.62044978e-02f,3.16175036e-02f,1.77818574e-02f,9.99983400e-03f,5.62338345e-03f,3.16227227e-03f,1.77827850e-03f,-9.99990225e-01f,-9.72764567e-02f,-3.30574960e-01f,9.26681578e-01f,8.91207397e-01f,5.79875171e-01f,3.40877861e-01f,1.94365650e-01f,1.09778300e-01f,6.18181042e-02f,3.47780399e-02f,1.95598267e-02f,1.09997792e-02f,6.18571462e-03f,3.47849843e-03f,1.95610616e-03f,-5.36572933e-01f,4.48342979e-01f,-6.07683420e-01f,8.45583618e-01f,9.32039082e-01f,6.24748647e-01f,3.70431304e-01f,2.11777672e-01f,1.19712204e-01f,6.74297586e-02f,3.79382223e-02f,2.13377345e-02f,1.19997123e-02f,6.74804440e-03f,3.79472389e-03f,2.13393359e-03f,4.20167029e-01f,8.55880976e-01f,-8.24528456e-01f,7.37816215e-01f,9.63558197e-01f,6.67647004e-01f,3.99614304e-01f,2.29122713e-01f,1.29634142e-01f,7.30392784e-02f,4.10980321e-02f,2.31155735e-02f,1.29996343e-02f,7.31037185e-03f,4.11094911e-03f,2.31176103e-03f,9.90607381e-01f,9.99823332e-01f,-9.59605396e-01f,6.06778562e-01f,9.85449731e-01f,7.08434701e-01f,4.28397775e-01f,2.46395305e-01f,1.39543116e-01f,7.86464810e-02f,4.42574248e-02f,2.48933397e-02f,1.39995432e-02f,7.87269697e-03f,4.42717411e-03f,2.48958869e-03f,6.50287867e-01f,8.35838437e-01f,-9.99518692e-01f,4.56603259e-01f,9.97494996e-01f,7.46982634e-01f,4.56752867e-01f,2.63589978e-01f,1.49438128e-01f,8.42512026e-02f,4.74163815e-02f,2.66710296e-02f,1.49994381e-02f,8.43502022e-03f,4.74339863e-03f,2.66741589e-03f,-2.87903309e-01f,4.14430231e-01f,-9.40310359e-01f,2.92027086e-01f,9.99573588e-01f,7.83169091e-01f,4.84651238e-01f,2.80701309e-01f,1.59318209e-01f,8.98532644e-02f,5.05748577e-02f,2.84486320e-02f,1.59993190e-02f,8.99733976e-03f,5.05962269e-03f,2.84524332e-03f,-9.61397469e-01f,-1.34615138e-01f,-7.87851870e-01f,1.18240520e-01f,9.91664827e-01f,8.16879570e-01f,5.12064993e-01f,2.97723860e-01f,1.69182345e-01f,9.54524800e-02f,5.37328273e-02f,3.02261449e-02f,1.69991814e-02f,9.55965649e-03f,5.37584582e-03f,3.02307028e-03f,-7.50987232e-01f,-6.42200708e-01f,-5.57262897e-01f,-5.92755191e-02f,9.73847628e-01f,8.48007560e-01f,5.38966715e-01f,3.14652264e-01f,1.79029569e-01f,1.01048686e-01f,5.68902642e-02f,3.20035629e-02f,1.79990288e-02f,1.01219704e-02f,5.69206895e-03f,3.20089748e-03f,1.49877205e-01f,-9.52000856e-01f,-2.71410108e-01f,-2.34921798e-01f,9.46300089e-01f,8.76454532e-01f,5.65329552e-01f,3.31481189e-01f,1.88858896e-01f,1.06641680e-01f,6.00471310e-02f,3.37808803e-02f,1.89988576e-02f,1.06842816e-02f,6.00829115e-03f,3.37872445e-03f,9.12945271e-01f,-9.68601942e-01f,4.13582884e-02f,-4.03158993e-01f,9.09297407e-01f,9.02130723e-01f,5.91127038e-01f,3.48205268e-01f,1.98669314e-01f,1.12231314e-01f,6.32033944e-02f,3.55580896e-02f,1.99986678e-02f,1.12465890e-02f,6.32451288e-03f,3.55655141e-03f,8.36655617e-01f,-6.86891198e-01f,3.50024760e-01f,-5.58680534e-01f,8.63209307e-01f,9.24954832e-01f,6.16333544e-01f,3.64819258e-01f,2.08459899e-01f,1.17817394e-01f,6.63590282e-02f,3.73351872e-02f,2.09984574e-02f,1.18088927e-02f,6.64073415e-03f,3.73437814e-03f,-8.85130931e-03f,-1.93630233e-01f,6.23979926e-01f,-6.96581721e-01f,8.08496356e-01f,9.44854796e-01f,6.40923738e-01f,3.81317884e-01f,2.18229622e-01f,1.23399742e-01f,6.95140064e-02f,3.91121693e-02f,2.19982266e-02f,1.23711927e-02f,6.95695449e-03f,3.91220488e-03f,-8.46220434e-01f,3.59264523e-01f,8.36055279e-01f,-8.12512875e-01f,7.45705247e-01f,9.61767614e-01f,6.64873064e-01f,3.97695929e-01f,2.27977514e-01f,1.28978193e-01f,7.26682767e-02f,4.08890247e-02f,2.29979735e-02f,1.29334899e-02f,7.27317436e-03f,4.09003161e-03f,-9.05578375e-01f,8.01513135e-01f,9.65219259e-01f,-9.02817786e-01f,6.75463140e-01f,9.75639880e-01f,6.88157499e-01f,4.13948208e-01f,2.37702623e-01f,1.34552568e-01f,7.58218244e-02f,4.26657498e-02f,2.39976961e-02f,1.34957815e-02f,7.58939330e-03f,4.26785741e-03f,-1.32351756e-01f,9.96909976e-01f,9.98663187e-01f,-9.64648306e-01f,5.98472118e-01f,9.86427724e-01f,7.10753918e-01f,4.30069596e-01f,2.47403964e-01f,1.40122697e-01f,7.89746121e-02f,4.44423407e-02f,2.49973964e-02f,1.40580693e-02f,7.90561177e-03f,4.44568414e-03f,7.62558460e-01f,8.85276794e-01f,9.33070183e-01f,-9.96054351e-01f,5.15501261e-01f,9.94096994e-01f,7.32639611e-01f,4.46054995e-01f,2.57080555e-01f,1.45688385e-01f,8.21266174e-02f,4.62187938e-02f,2.59970706e-02f,1.46203535e-02f,8.22182931e-03f,4.62350994e-03f,9.56375957e-01f,5.00994205e-01f,7.74945021e-01f,-9.96045172e-01f,4.27379847e-01f,9.98623490e-01f,7.53792703e-01f,4.61899310e-01f,2.66731411e-01f,1.51249468e-01f,8.52777958e-02f,4.79951017e-02f,2.69967206e-02f,1.51826320e-02f,8.53804592e-03f,4.80133574e-03f,2.70905793e-01f,-3.75856608e-02f,5.39968967e-01f,-9.64621305e-01f,3.34988207e-01f,9.99992907e-01f,7.74192095e-01f,4.77597594e-01f,2.76355654e-01f,1.56805754e-01f,8.84281173e-02f,4.97712530e-02f,2.79963426e-02f,1.57449059e-02f,8.85426160e-03f,4.97916201e-03f,-6.63633883e-01f,-5.64589798e-01f,2.51445323e-01f,-9.02773678e-01f,2.39249229e-01f,9.98200953e-01f,7.93817401e-01f,4.93144840e-01f,2.85952210e-01f,1.62357092e-01f,9.15775672e-02f,5.15472479e-02f,2.89959367e-02f,1.63071752e-02f,9.17047635e-03f,5.15698735e-03f,-9.88031626e-01f,-9.17709649e-01f,-6.20148405e-02f,-8.12452853e-01f,1.41120002e-01f,9.93253171e-01f,8.12648892e-01f,5.08536100e-01f,2.95520186e-01f,1.67903304e-01f,9.47260931e-02f,5.33230826e-02f,2.99955010e-02f,1.68694388e-02f,9.48669016e-03f,5.33481315e-03f,-4.04037654e-01f,-9.88192797e-01f,-3.69325012e-01f,-6.96507812e-01f,4.15805206e-02f,9.85165298e-01f,8.30667794e-01f,5.23766637e-01f,3.05058628e-01f,1.73444211e-01f,9.78736654e-02f,5.50987460e-02f,3.09950355e-02f,1.74316969e-02f,9.80290305e-03f,5.51263802e-03f,5.51426709e-01f,-7.54330218e-01f,-6.40009403e-01f,-5.58595300e-01f,-5.83741926e-02f,9.73962843e-01f,8.47856104e-01f,5.38831532e-01f,3.14566553e-01f,1.78979620e-01f,1.01020269e-01f,5.68742342e-02f,3.19945402e-02f,1.79939512e-02f,1.01191159e-02f,5.69046335e-03f,9.99911845e-01f,-2.88147390e-01f,-8.47224355e-01f,-4.03064936e-01f,-1.57745644e-01f,9.59681332e-01f,8.64196658e-01f,5.53726017e-01f,3.24043006e-01f,1.84509367e-01f,1.04165860e-01f,5.86495437e-02f,3.29940096e-02f,1.85561981e-02f,1.04353270e-02f,5.86828869e-03f,5.29082716e-01f,2.66779721e-01f,-9.70420420e-01f,-2.34822124e-01f,-2.55541205e-01f,9.42365825e-01f,8.79673064e-01f,5.68445385e-01f,3.33487093e-01f,1.90033287e-01f,1.07310407e-01f,6.04246669e-02f,3.39934528e-02f,1.91184394e-02f,1.07515370e-02f,6.04611309e-03f,-4.28182662e-01f,7.39542127e-01f,-9.97380435e-01f,-5.91726787e-02f,-3.50783229e-01f,9.22071040e-01f,8.94269884e-01f,5.82984984e-01f,3.42897803e-01f,1.95551202e-01f,1.10453881e-01f,6.21996038e-02f,3.49928550e-02f,1.96806751e-02f,1.10677453e-02f,6.22393796e-03f,-9.91778851e-01f,9.84540582e-01f,-9.25431013e-01f,1.18342586e-01f,-4.42520559e-01f,8.98861170e-01f,9.07972515e-01f,5.97340286e-01f,3.52274209e-01f,2.01062918e-01f,1.13596253e-01f,6.39743358e-02f,3.59922275e-02f,2.02429052e-02f,1.13839535e-02f,6.40176190e-03f,-6.43538117e-01f,9.26318109e-01f,-7.61706948e-01f,2.92125374e-01f,-5.29836178e-01f,8.72809589e-01f,9.20767248e-01f,6.11506701e-01f,3.61615449e-01f,2.06568271e-01f,1.16737492e-01f,6.57488778e-02f,3.69915590e-02f,2.08051261e-02f,1.17001599e-02f,6.57958630e-03f,2.96368569e-01f,5.82806170e-01f,-5.22444785e-01f,4.56694692e-01f,-6.11857831e-01f,8.43998730e-01f,9.32641268e-01f,6.25479698e-01f,3.70920479e-01f,2.12067112e-01f,1.19877554e-01f,6.75232038e-02f,3.79908569e-02f,2.13673431e-02f,1.20163653e-02f,6.75741071e-03f,9.63795364e-01f,5.98003156e-02f,-2.31372014e-01f,6.06860459e-01f,-6.87766254e-01f,8.12519610e-01f,9.43582714e-01f,6.39254928e-01f,3.80188406e-01f,2.17559248e-01f,1.23016424e-01f,6.92973137e-02f,3.89901139e-02f,2.19295528e-02f,1.23325698e-02f,6.93523418e-03f,7.45113134e-01f,-4.81621295e-01f,8.26458037e-02f,7.37885714e-01f,-7.56802499e-01f,7.78471708e-01f,9.53580678e-01f,6.52827978e-01f,3.89418334e-01f,2.23044485e-01f,1.26154065e-01f,7.10712075e-02f,3.99893373e-02f,2.24917568e-02f,1.26487734e-02f,7.11305765e-03f,-1.58622667e-01f,-8.74714017e-01f,3.88467699e-01f,8.45638454e-01f,-8.18277061e-01f,7.41962790e-01f,9.62625206e-01f,6.66194677e-01f,3.98609310e-01f,2.28522688e-01f,1.29290432e-01f,7.28448778e-02f,4.09885161e-02f,2.30539497e-02f,1.29649751e-02f,7.29088066e-03f,-9.16521549e-01f,-9.98410463e-01f,6.55764699e-01f,9.26720202e-01f,-8.71575892e-01f,7.03108132e-01f,9.70707119e-01f,6.79350674e-01f,4.07760441e-01f,2.33993664e-01f,1.32425532e-01f,7.46183172e-02f,4.19876575e-02f,2.36161388e-02f,1.32811759e-02f,7.46870413e-03f,-8.31774771e-01f,-8.14614236e-01f,8.58030677e-01f,9.78573620e-01f,-9.16166008e-01f,6.62030637e-01f,9.77818429e-01f,6.92291796e-01f,4.16870773e-01f,2.39457220e-01f,1.35559291e-01f,7.63915181e-02f,4.29867506e-02f,2.41783205e-02f,1.35973748e-02f,7.64652714e-03f,1.77019257e-02f,-3.79931390e-01f,9.75206196e-01f,9.99563396e-01f,-9.51602101e-01f,6.18860185e-01f,9.83951986e-01f,7.05014050e-01f,4.25939471e-01f,2.44913206e-01f,1.38691694e-01f,7.81644881e-02f,4.39858064e-02f,2.47404929e-02f,1.39135728e-02f,7.82434922e-03f,8.50903511e-01f,1.71763569e-01f,9.95670974e-01f,9.89027262e-01f,-9.77530122e-01f,5.73733270e-01f,9.89101648e-01f,7.17513323e-01f,4.34965521e-01f,2.50361472e-01f,1.41822711e-01f,7.99371973e-02f,4.49848175e-02f,2.53026579e-02f,1.42297689e-02f,8.00217129e-03f,9.01788354e-01f,6.70557022e-01f,9.17395473e-01f,9.47297752e-01f,-9.93690968e-01f,5.26792526e-01f,9.93262351e-01f,7.29785740e-01f,4.43948090e-01f,2.55801797e-01f,1.44952312e-01f,8.17096606e-02f,4.59837839e-02f,2.58648153e-02f,1.45459641e-02f,8.17999430e-03f,1.23573124e-01f,9.62832689e-01f,7.48142362e-01f,8.75690997e-01f,-9.99923289e-01f,4.78186339e-01f,9.96429801e-01f,7.41827428e-01f,4.52886283e-01f,2.61234075e-01f,1.48080453e-01f,8.34818557e-02f,4.69827019e-02f,2.64269635e-02f,1.48621574e-02f,8.35781638e-03f,-7.68254638e-01f,9.58573103e-01f,5.04697084e-01f,7.76465356e-01f,-9.96164620e-01f,4.28068399e-01f,9.98600960e-01f,7.53634512e-01f,4.61779177e-01f,2.66658038e-01f,1.51207119e-01f,8.52537975e-02f,4.79815714e-02f,2.69891042e-02f,1.51783489e-02f,8.53563752e-03f,-9.53752637e-01f,6.59090102e-01f,2.11200655e-01f,6.52750373e-01f,-9.82452571e-01f,3.76597136e-01f,9.99773562e-01f,7.65203178e-01f,4.70625877e-01f,2.72073567e-01f,1.54332280e-01f,8.70254710e-02f,4.89803962e-02f,2.75512375e-02f,1.54945394e-02f,8.71345960e-03f,-2.62374848e-01f,1.56619072e-01f,-1.03240460e-01f,5.08447945e-01f,-9.58924294e-01f,3.23935270e-01f,9.99946535e-01f,7.76529968e-01f,4.79425550e-01f,2.77480543e-01f,1.57455891e-01f,8.87968615e-02f,4.99791689e-02f,2.81133596e-02f,1.58107281e-02f,8.89127981e-03f,6.70229197e-01f,-3.94086063e-01f,-4.07444149e-01f,3.48108500e-01f,-9.25814748e-01f,2.70249337e-01f,9.99119580e-01f,7.87611187e-01f,4.88177240e-01f,2.82878697e-01f,1.60577938e-01f,9.05679762e-02f,5.09778969e-02f,2.86754742e-02f,1.61269177e-02f,9.06910095e-03f,9.86627579e-01f,-8.23421597e-01f,-6.71240151e-01f,1.76790684e-01f,-8.83454502e-01f,2.15709001e-01f,9.97293651e-01f,7.98443377e-01f,4.96880114e-01f,2.88267940e-01f,1.63698375e-01f,9.23388004e-02f,5.19765690e-02f,2.92375814e-02f,1.64431017e-02f,9.24692024e-03f,3.95925164e-01f,-9.99157965e-01f,-8.68469954e-01f,-1.03020677e-04f,-8.32267344e-01f,1.60486728e-01f,9.94470477e-01f,8.09023023e-01f,5.05533338e-01f,2.93648034e-01f,1.66817173e-01f,9.41093415e-02f,5.29751927e-02f,2.97996756e-02f,1.67592876e-02f,9.42474138e-03f,-5.58789074e-01f,-8.67171526e-01f,-9.79574919e-01f,-1.76993474e-01f,-7.72764444e-01f,1.04756832e-01f,9.90652919e-01f,8.19346905e-01f,5.14135957e-01f,2.99018890e-01f,1.69934288e-01f,9.58795771e-02f,5.39737605e-02f,3.03617641e-02f,1.70754679e-02f,9.60256159e-03f,-9.99755144e-01f,-4.68111664e-01f,-9.93535519e-01f,-3.48301649e-01f,-7.05540299e-01f,4.86960001e-02f,9.85844791e-01f,8.29411685e-01f,5.22687256e-01f,3.04380238e-01f,1.73049718e-01f,9.76495072e-02f,5.49722798e-02f,3.09238415e-02f,1.73916500e-02f,9.78038087e-03f,-5.21551013e-01f,7.51182064e-02f,-9.08967435e-01f,-5.08624554e-01f,-6.31266713e-01f,-7.51878507e-03f,9.80050862e-01f,8.39214146e-01f,5.31186223e-01f,3.09731960e-01f,1.76163420e-01f,9.94191393e-02f,5.59707358e-02f,3.14859077e-02f,1.77078284e-02f,9.95820016e-03f,4.36164767e-01f,5.95211506e-01f,-7.34258294e-01f,-6.52905703e-01f,-5.50685287e-01f,-6.37097955e-02f,9.73276973e-01f,8.48751247e-01f,5.39632022e-01f,3.15073937e-01f,1.79275364e-01f,1.01188451e-01f,5.69691435e-02f,3.20479684e-02f,1.80240069e-02f,1.01360194e-02f,9.92872655e-01f,9.31992829e-01f,-4.86733496e-01f,-7.76594579e-01f,-4.64602023e-01f,-1.19699396e-01f,9.65529919e-01f,8.58020008e-01f,5.48023939e-01f,3.20405900e-01f,1.82385504e-01f,1.02957435e-01f,5.79674877e-02f,3.26100141e-02f,1.83401816e-02f,1.03138378e-02f,6.36738002e-01f,9.81735826e-01f,-1.90938011e-01f,-8.75790000e-01f,-3.73876572e-01f,-1.75310582e-01f,9.56817448e-01f,8.67017388e-01f,5.56361020e-01f,3.25727791e-01f,1.85493827e-01f,1.04726106e-01f,5.89657798e-02f,3.31720486e-02f,1.86563563e-02f,1.04916561e-02f,-3.04810613e-01f,7.29123712e-01f,1.23790950e-01f,-9.47363734e-01f,-2.79415488e-01f,-2.30367512e-01f,9.47148204e-01f,8.75740528e-01f,5.64642429e-01f,3.31039310e-01f,1.88600287e-01f,1.06494442e-01f,5.99640086e-02f,3.37340795e-02f,1.89725272e-02f,1.06694745e-02f,-9.66117799e-01f,2.51952261e-01f,4.26245421e-01f,-9.89057720e-01f,-1.82162598e-01f,-2.84696162e-01f,9.36531842e-01f,8.84186864e-01f,5.72867453e-01f,3.36340427e-01f,1.91704854e-01f,1.08262435e-01f,6.09621815e-02f,3.42960916e-02f,1.92886982e-02f,1.08472919e-02f,-7.39180684e-01f,-3.02812874e-01f,6.86427653e-01f,-9.99557257e-01f,-8.30891207e-02f,-3.38124752e-01f,9.24979091e-01f,8.92353535e-01f,5.81035137e-01f,3.41630876e-01f,1.94807529e-01f,1.10030092e-01f,6.19602874e-02f,3.48580964e-02f,1.96048655e-02f,1.10251084e-02f,1.67355701e-01f,-7.64320076e-01f,8.78538549e-01f,-9.78531301e-01f,1.68140903e-02f,-3.90484393e-01f,9.12501454e-01f,9.00238097e-01f,5.89144766e-01f,3.46910536e-01f,1.97908238e-01f,1.11797392e-01f,6.29583374e-02f,3.54200937e-02f,1.99210308e-02f,1.12029258e-02f};


constexpr int D = 1024, NB = 16, T = 4096, CL = 256;
constexpr int NLAT = NB * T, NCTX = NB * CL, NR = NLAT + NCTX;
constexpr int DFF = 2688, DFF2 = 5376, AB_IN = 1280, C_IN = 1536;
constexpr float EPS = 1e-6f;
constexpr float LOG2E = 1.4426950408889634f;
constexpr float QSCALE = 0.125f * LOG2E;
constexpr int RING_BYTES = 131072, EX_BYTES = 16384, CW_BYTES = 8192, LDS_BYTES = RING_BYTES + EX_BYTES + CW_BYTES;
constexpr int NTHR = 512, NWAVE = 8;
constexpr int NPHASE = 30;

struct Params {
    const float *x, *c, *ctx, *c_ctx, *ada_w, *ada_b, *mix_pre_g, *mix_post_g, *ffn_pre_g, *ffn_post_g;
    const float *ab_w_in, *ab_w_out, *pool_w, *pool_scale, *sink_logit, *c_w_qkv, *c_w_out, *c_q_g, *c_k_g;
    const float *ffn_w_up, *ffn_conv_w, *ffn_conv_b, *ffn_w_down;
    float* out;
    bf16_t* xres;
    bf16_t* H;
    bf16_t* Y;
    bf16_t* PG;
    float* ada;
    unsigned* bar;
    bf16_t* wt_in_b;
    bf16_t* wt_out_b;
    bf16_t* wt_up_b;
    bf16_t* wt_down_b;
    bf16_t* wt_pool_b;
    DI bf16_t* wt_in(int l) const { return wt_in_b + (size_t)l * C_IN * D; }
    DI bf16_t* wt_out(int l) const { return wt_out_b + (size_t)l * D * D; }
    DI bf16_t* wt_up(int l) const { return wt_up_b + (size_t)l * DFF2 * D; }
    DI bf16_t* wt_down(int l) const { return wt_down_b + (size_t)l * D * DFF; }
    DI bf16_t* wt_pool(int li) const { return wt_pool_b + (size_t)li * 4 * 128 * 128; }
    int ph_lo, ph_hi;
};

DI int get_tid() { int t = threadIdx.x; asm volatile("" : "+v"(t)); return t; }
DI float shx(float v, int k, int lane) { return __builtin_bit_cast(float, __builtin_amdgcn_ds_bpermute((lane ^ k) << 2, __builtin_bit_cast(int, v))); }
DI unsigned pack2(float lo, float hi) { f32x2 v = {lo, hi}; bf16x2_t b = __builtin_convertvector(v, bf16x2_t); return __builtin_bit_cast(unsigned, b); }
DI float bf2f(unsigned v16) { return __uint_as_float(v16 << 16); }
DI int crow(int i, int h) { return (i & 3) + 8 * (i >> 2) + 4 * h; }
#define MFMA32(a, b, c) __builtin_amdgcn_mfma_f32_32x32x16_bf16((a), (b), (c), 0, 0, 0)
DI float opaque0() { float z; asm volatile("v_mov_b32 %0, 0" : "=v"(z)); return z; }
DI float fast_exp2(float x) { return __builtin_amdgcn_exp2f(x); }
DI float sigmoidf_(float x) { return 1.0f / (1.0f + __expf(-x)); }
DI float gelu_tanh(float x) {
    const float u = x * x, t = x * (u * (-2.0f * 0.7978845608028654f * 0.044715f * LOG2E) + (-2.0f * 0.7978845608028654f * LOG2E));
    return x * __builtin_amdgcn_rcpf(1.0f + fast_exp2(t)); }


constexpr int BM = 256, BK = 64, HALF = 128, HTB = HALF * BK * 2, NXCD = 8, WGM = 8;
DI int lds_byte(int r, int c) { const int st = (r >> 4) * 2 + (c >> 5), rr = r & 15, cc = c & 31, ob = rr * 64 + cc * 2; return st * 1024 + (ob ^ (((ob >> 9) & 1) << 5)); }
DI void stage_rc(int b, int& R, int& C) { const int st = b / 1024, sb = b % 1024, swz = sb ^ (((sb >> 9) & 1) << 5); R = (st >> 1) * 16 + swz / 64; C = (st & 1) * 32 + (swz % 64) / 2; }
DI int perm32(int rho) { const int n = rho >> 4, i = rho & 15; return 8 * (i >> 2) + 4 * n + (i & 3); }
struct Unit { int pm, pn, seq; };
struct Gemm { const bf16_t* A; const bf16_t* Bt; int K; size_t a_tstep; };
struct StaticOrder {
    int nM, nN, nwg, G, c;
    DI void init(int nM_, int nN_, int G_, int c_) { nM = nM_; nN = nN_; nwg = nM * nN; G = G_; c = c_; }
    DI bool next(int i, Unit& u) const {
        const long L = (long)i * G + c; if (L >= nwg) return false;
        int wgid = (int)L; { const int q = nwg / NXCD, r = nwg % NXCD, xcd = wgid % NXCD, off = wgid / NXCD; wgid = (xcd < r ? xcd * (q + 1) : r * (q + 1) + (xcd - r) * q) + off; }
        const int nig = WGM * nN, gid = wgid / nig, fm = gid * WGM, gsz = (nM - fm) < WGM ? (nM - fm) : WGM;
        u.pm = fm + ((wgid % nig) % gsz); u.pn = (wgid % nig) / gsz; u.seq = i; return true;
    }
    DI void a_ready(const Unit&) const {}
    DI void done(const Unit&) const {}
};
template <class Epi, class Sched, bool ALIGN_EPI = false, bool SP2 = false>
__device__ __forceinline__ void gemm_phase(LAS unsigned char* lds, const Gemm g, const Sched& S, const Epi& E) {
    const int tid = get_tid(), wid = __builtin_amdgcn_readfirstlane(tid >> 6), lane = tid & 63, wr = wid >> 2, wc = wid & 3, fr = lane & 15, fq = lane >> 4;
    const int K = g.K, nt = K / BK;
    unsigned voffA[2], voffB[2];
#pragma unroll
    for (int i = 0; i < 2; ++i) { int R, C; stage_rc(tid * 16 + i * 8192, R, C); const int Rb = Epi::PERM ? ((R & ~31) + perm32(R & 31)) : R;
        voffA[i] = (unsigned)(R * K + C) * 2u; voffB[i] = (unsigned)(Rb * K + C) * 2u; }
    const size_t kstep = (size_t)(BK * 2);
    const size_t hstep = (size_t)HALF * K * 2;
    const size_t tstep = 2 * hstep;
    const unsigned ldsw = (unsigned)wid * 1024u;
    const int aoff = lds_byte(wr * 64 + fr, fq * 8), boff = lds_byte(wc * 32 + fr, fq * 8);
#define PG8_SA(b, h) (((b) * 2 + (h)) * HTB)
#define PG8_SB(b, h) ((4 + (b) * 2 + (h)) * HTB)
#define PG8_STAGE(bufoff, gbase, voff) do { _Pragma("unroll") for (int _i = 0; _i < 2; ++_i) \
        __builtin_amdgcn_global_load_lds((const unsigned*)((const char*)(gbase) + (voff)[_i]), (LAS unsigned*)(lds + (bufoff) + ldsw + _i * 8192), 16, 0, 0); } while (0)
#define PG8_LDA(dst, b, h) do { _Pragma("unroll") for (int m = 0; m < 4; ++m) _Pragma("unroll") for (int k = 0; k < 2; ++k) dst[m][k] = *(const LAS bf16x8*)(lds + PG8_SA(b, h) + aoff + m * 2048 + k * 1024); } while (0)
#define PG8_LDB(dst, b, h) do { _Pragma("unroll") for (int n = 0; n < 2; ++n) _Pragma("unroll") for (int k = 0; k < 2; ++k) dst[n][k] = *(const LAS bf16x8*)(lds + PG8_SB(b, h) + boff + n * 2048 + k * 1024); } while (0)
#define PG8_MMA(ai, bj, At, Bt) do { __builtin_amdgcn_s_setprio(1); _Pragma("unroll") for (int m = 0; m < 4; ++m) _Pragma("unroll") for (int n = 0; n < 2; ++n) _Pragma("unroll") for (int k = 0; k < 2; ++k) \
        acc[ai][bj][m][n] = __builtin_amdgcn_mfma_f32_16x16x32_bf16(Bt[n][k], At[m][k], acc[ai][bj][m][n], 0, 0, 0); __builtin_amdgcn_s_setprio(0); } while (0)
#define PG8_WAIT_V(n) asm volatile("s_waitcnt vmcnt(" #n ")" ::: "memory")
#define PG8_WAIT_L(n) asm volatile("s_waitcnt lgkmcnt(" #n ")" ::: "memory")
#define PG8_BAR __builtin_amdgcn_s_barrier()
#define PG8_SCHED __builtin_amdgcn_sched_barrier(0)
    Unit cur, nxt; int ui = 0;
    if (!S.next(0, cur)) return;
    f32x4 acc[2][2][4][2];
#pragma unroll
    for (int a = 0; a < 2; ++a)
#pragma unroll
        for (int b = 0; b < 2; ++b)
#pragma unroll
            for (int m = 0; m < 4; ++m)
#pragma unroll
                for (int n = 0; n < 2; ++n) acc[a][b][m][n] = (f32x4){0.f, 0.f, 0.f, 0.f};
    bf16x8 At[4][2], B0[2][2], B1[2][2];
    const char* cA = (const char*)g.A + (size_t)cur.pm * g.a_tstep; const char* cB = (const char*)g.Bt + (size_t)cur.pn * tstep;
    S.a_ready(cur);
    if constexpr (SP2) {
        PG8_STAGE(PG8_SB(0, 0), cB, voffB); PG8_STAGE(PG8_SB(0, 1), cB + hstep, voffB); PG8_STAGE(PG8_SA(0, 0), cA, voffA); PG8_STAGE(PG8_SA(0, 1), cA + hstep, voffA);
        if (wr == 1) PG8_BAR;
        PG8_WAIT_V(2); PG8_BAR;
        PG8_STAGE(PG8_SB(1, 0), cB + kstep, voffB); PG8_STAGE(PG8_SA(1, 0), cA + kstep, voffA); PG8_STAGE(PG8_SB(1, 1), cB + hstep + kstep, voffB);
        PG8_WAIT_V(6); PG8_BAR;
    } else {
        PG8_STAGE(PG8_SB(0, 0), cB, voffB); PG8_STAGE(PG8_SA(0, 0), cA, voffA); PG8_STAGE(PG8_SB(0, 1), cB + hstep, voffB); PG8_STAGE(PG8_SA(0, 1), cA + hstep, voffA);
        if (wr == 1) PG8_BAR;
        PG8_WAIT_V(4); PG8_BAR;
        PG8_STAGE(PG8_SB(1, 0), cB + kstep, voffB); PG8_STAGE(PG8_SA(1, 0), cA + kstep, voffA); PG8_STAGE(PG8_SB(1, 1), cB + hstep + kstep, voffB);
        PG8_WAIT_V(6); PG8_BAR;
    }
    for (;;) {
        const bool has_next = S.next(ui + 1, nxt);
        const char* nA = has_next ? (const char*)g.A + (size_t)nxt.pm * g.a_tstep : cA; const char* nB = has_next ? (const char*)g.Bt + (size_t)nxt.pn * tstep : cB;
        for (int t = 0; t < nt; t += 2) {
            const bool last = (t == nt - 2);
            const char* a1 = cA + (size_t)(t + 1) * kstep;
            const char* a2 = last ? nA : cA + (size_t)(t + 2) * kstep; const char* b2 = last ? nB : cB + (size_t)(t + 2) * kstep;
            const char* a3 = a2 + kstep; const char* b3 = b2 + kstep;
            if (last && has_next) S.a_ready(nxt);
            if constexpr (SP2) {
            PG8_LDB(B0, 0, 0); PG8_LDB(B1, 0, 1); PG8_SCHED; PG8_LDA(At, 0, 0); PG8_STAGE(PG8_SA(1, 1), a1 + hstep, voffA);
            PG8_WAIT_V(8); PG8_WAIT_L(0); PG8_BAR; PG8_MMA(0, 0, At, B0); PG8_MMA(0, 1, At, B1); PG8_BAR; PG8_SCHED;
            PG8_LDA(At, 0, 1); PG8_STAGE(PG8_SB(0, 0), b2, voffB); PG8_STAGE(PG8_SB(0, 1), b2 + hstep, voffB); PG8_STAGE(PG8_SA(0, 0), a2, voffA);
            PG8_WAIT_V(8); PG8_WAIT_L(0); PG8_BAR; PG8_MMA(1, 0, At, B0); PG8_MMA(1, 1, At, B1); PG8_BAR; PG8_SCHED;
            PG8_LDB(B0, 1, 0); PG8_LDB(B1, 1, 1); PG8_SCHED; PG8_LDA(At, 1, 0); PG8_STAGE(PG8_SA(0, 1), a2 + hstep, voffA);
            PG8_WAIT_V(8); PG8_WAIT_L(0); PG8_BAR; PG8_MMA(0, 0, At, B0); PG8_MMA(0, 1, At, B1); PG8_BAR; PG8_SCHED;
            PG8_LDA(At, 1, 1); PG8_STAGE(PG8_SB(1, 0), b3, voffB); PG8_STAGE(PG8_SB(1, 1), b3 + hstep, voffB); PG8_STAGE(PG8_SA(1, 0), a3, voffA);
            PG8_WAIT_V(8); PG8_WAIT_L(0); PG8_BAR; PG8_MMA(1, 0, At, B0); PG8_MMA(1, 1, At, B1); PG8_BAR; PG8_SCHED;
            } else {
            PG8_LDB(B0, 0, 0); PG8_SCHED; PG8_LDA(At, 0, 0); PG8_STAGE(PG8_SA(1, 1), a1 + hstep, voffA);
            PG8_WAIT_L(8); PG8_BAR; PG8_WAIT_L(0); PG8_MMA(0, 0, At, B0); PG8_BAR; PG8_SCHED;
            PG8_LDB(B1, 0, 1); PG8_STAGE(PG8_SB(0, 0), b2, voffB);
            PG8_BAR; PG8_WAIT_L(0); PG8_MMA(0, 1, At, B1); PG8_BAR;
            PG8_LDA(At, 0, 1); PG8_STAGE(PG8_SA(0, 0), a2, voffA);
            PG8_BAR; PG8_WAIT_L(0); PG8_MMA(1, 0, At, B0); PG8_BAR; PG8_SCHED;
            PG8_STAGE(PG8_SB(0, 1), b2 + hstep, voffB);
            PG8_WAIT_V(6); PG8_BAR; PG8_MMA(1, 1, At, B1); PG8_BAR;
            PG8_LDB(B0, 1, 0); PG8_SCHED; PG8_LDA(At, 1, 0); PG8_STAGE(PG8_SA(0, 1), a2 + hstep, voffA);
            PG8_WAIT_L(8); PG8_BAR; PG8_WAIT_L(0); PG8_MMA(0, 0, At, B0); PG8_BAR; PG8_SCHED;
            PG8_LDB(B1, 1, 1); PG8_STAGE(PG8_SB(1, 0), b3, voffB);
            PG8_BAR; PG8_WAIT_L(0); PG8_MMA(0, 1, At, B1); PG8_BAR;
            PG8_LDA(At, 1, 1); PG8_STAGE(PG8_SA(1, 0), a3, voffA);
            PG8_BAR; PG8_WAIT_L(0); PG8_MMA(1, 0, At, B0); PG8_BAR; PG8_SCHED;
            PG8_STAGE(PG8_SB(1, 1), b3 + hstep, voffB);
            PG8_WAIT_V(6); PG8_BAR; PG8_MMA(1, 1, At, B1); PG8_BAR;
            }
        }
        if constexpr (ALIGN_EPI) { if (wr == 0) PG8_BAR; }
        if constexpr (!Epi::AFTER_DRAIN) { E(acc, cur, wr, wc, fr, fq); S.done(cur); }
        if (!has_next) break;
#pragma unroll
        for (int a = 0; a < 2; ++a)
#pragma unroll
            for (int b = 0; b < 2; ++b)
#pragma unroll
                for (int m = 0; m < 4; ++m)
#pragma unroll
                    for (int n = 0; n < 2; ++n) acc[a][b][m][n] = (f32x4){0.f, 0.f, 0.f, 0.f};
        cur = nxt; cA = nA; cB = nB; ++ui;
        if constexpr (ALIGN_EPI) { if (wr == 1) PG8_BAR; }
    }
    PG8_WAIT_V(0);
    if constexpr (!ALIGN_EPI) { if (wr == 0) PG8_BAR; }
    PG8_BAR;
    if constexpr (Epi::AFTER_DRAIN) { E.fused(acc, cur, wr, wc, fr, fq, lds, wid, lane); S.done(cur); }
#undef PG8_SA
#undef PG8_SB
#undef PG8_STAGE
#undef PG8_LDA
#undef PG8_LDB
#undef PG8_MMA
#undef PG8_WAIT_V
#undef PG8_WAIT_L
#undef PG8_BAR
#undef PG8_SCHED
}


struct EpiY {
    static constexpr bool PERM = true, AFTER_DRAIN = false;
    bf16_t* O;
    DI void operator()(const f32x4 (&acc)[2][2][4][2], const Unit& u, int wr, int wc, int fr, int fq) const {
        const int row0 = u.pm * BM + wr * 64 + fr, col0 = u.pn * BM + wc * 32 + 8 * fq;
#pragma unroll
        for (int ai = 0; ai < 2; ++ai)
#pragma unroll
            for (int m = 0; m < 4; ++m) {
                bf16_t* rowp = O + (size_t)(row0 + ai * HALF + m * 16) * D + col0;
#pragma unroll
                for (int bj = 0; bj < 2; ++bj) {
                    const f32x4 v0 = acc[ai][bj][m][0], v1 = acc[ai][bj][m][1];
                    u32x4 w; w.x = pack2(v0[0], v0[1]); w.y = pack2(v0[2], v0[3]); w.z = pack2(v1[0], v1[1]); w.w = pack2(v1[2], v1[3]);
                    *(u32x4*)(rowp + bj * HALF) = w;
                }
            }
    }
};
struct EpiIn {
    static constexpr bool PERM = true, AFTER_DRAIN = false;
    bf16_t* P; int even; const float* qg; const float* kg;
    DI void operator()(const f32x4 (&acc)[2][2][4][2], const Unit& u, int wr, int wc, int fr_in, int fq_in) const {
        int fr = fr_in, fq = fq_in;
        asm volatile("" : "+v"(fr), "+v"(fq));
        const int cb = u.pn * 256 + wc * 64;
        bf16_t* dst; int ld, dcol; const float* gain = nullptr; bool rope = false; float scale = 1.f;
        if (even) {
            if (cb < 512) { dst = P; ld = 512; dcol = cb; }
            else if (cb < 1024) { dst = P + (size_t)NR * 512; ld = 512; dcol = cb - 512; rope = true; scale = QSCALE; }
            else if (cb < 1152) { dst = P + (size_t)NR * 1024; ld = 128; dcol = cb - 1024; rope = true; }
            else { dst = P + (size_t)NR * 1152; ld = 128; dcol = cb - 1152; }
        } else {
            if (cb < 1024) { dst = P; ld = 1024; dcol = cb; gain = qg; rope = true; scale = QSCALE; }
            else if (cb < 1280) { dst = P + (size_t)NR * 1024; ld = 256; dcol = cb - 1024; gain = kg; rope = true; }
            else { dst = P + (size_t)NR * 1280; ld = 256; dcol = cb - 1280; }
        }
        f32x4 gn[2][2];
#pragma unroll
        for (int bj = 0; bj < 2; ++bj)
#pragma unroll
            for (int n = 0; n < 2; ++n) gn[bj][n] = gain ? *(const f32x4*)(gain + 32 * bj + 8 * fq + 4 * n) : (f32x4){1.f, 1.f, 1.f, 1.f};
#pragma unroll
        for (int ai = 0; ai < 2; ++ai)
#pragma unroll
            for (int m = 0; m < 4; ++m) {
                const int row = u.pm * BM + ai * HALF + wr * 64 + m * 16 + fr;
                f32x4 x[2][2];
#pragma unroll
                for (int bj = 0; bj < 2; ++bj)
#pragma unroll
                    for (int n = 0; n < 2; ++n) x[bj][n] = acc[ai][bj][m][n];
                if (gain) {
                    float ss = 0.f;
#pragma unroll
                    for (int bj = 0; bj < 2; ++bj)
#pragma unroll
                        for (int n = 0; n < 2; ++n)
#pragma unroll
                            for (int e = 0; e < 4; ++e) ss += x[bj][n][e] * x[bj][n][e];
                    ss += shx(ss, 16, fq * 16 + fr); ss += shx(ss, 32, fq * 16 + fr);
                    const float rinv = rsqrtf(ss * (1.0f / 64.0f) + EPS);
#pragma unroll
                    for (int bj = 0; bj < 2; ++bj)
#pragma unroll
                        for (int n = 0; n < 2; ++n) x[bj][n] = x[bj][n] * rinv * gn[bj][n];
                }
                if (rope && row < NLAT) {
                    const int t = row & (T - 1), pr = t >> 6, pc = t & 63;
                    const int idx = (fq < 2) ? (pr * 16 + 8 * fq) : (pc * 16 + 8 * fq - 16);
#pragma unroll
                    for (int n = 0; n < 2; ++n) {
                        const f32x4 cs = *(const f32x4*)(ROPE_COS + idx + 4 * n), sn = *(const f32x4*)(ROPE_SIN + idx + 4 * n);
                        const f32x4 x1 = x[0][n], x2 = x[1][n];
                        x[0][n] = x1 * cs - x2 * sn;
                        x[1][n] = x2 * cs + x1 * sn;
                    }
                }
                bf16_t* rp = dst + (size_t)row * ld + dcol + 8 * fq;
#pragma unroll
                for (int bj = 0; bj < 2; ++bj) {
                    const f32x4 v0 = x[bj][0] * scale, v1 = x[bj][1] * scale;
                    u32x4 w; w.x = pack2(v0[0], v0[1]); w.y = pack2(v0[2], v0[3]); w.z = pack2(v1[0], v1[1]); w.w = pack2(v1[2], v1[3]);
                    *(u32x4*)(rp + 32 * bj) = w;
                }
            }
    }
};
template <int DIR> DI void dpp_rot4(f32x4& r, const f32x4& x) {
    float r0, r1, r2, r3;
    if (DIR == 0)
        asm("s_nop 1\n\tv_mov_b32_dpp %0, %4 row_ror:1 row_mask:0xf bank_mask:0xf\n\tv_mov_b32_dpp %1, %5 row_ror:1 row_mask:0xf bank_mask:0xf\n\t"
            "v_mov_b32_dpp %2, %6 row_ror:1 row_mask:0xf bank_mask:0xf\n\tv_mov_b32_dpp %3, %7 row_ror:1 row_mask:0xf bank_mask:0xf"
            : "=&v"(r0), "=&v"(r1), "=&v"(r2), "=&v"(r3) : "v"(x[0]), "v"(x[1]), "v"(x[2]), "v"(x[3]));
    else
        asm("s_nop 1\n\tv_mov_b32_dpp %0, %4 row_ror:15 row_mask:0xf bank_mask:0xf\n\tv_mov_b32_dpp %1, %5 row_ror:15 row_mask:0xf bank_mask:0xf\n\t"
            "v_mov_b32_dpp %2, %6 row_ror:15 row_mask:0xf bank_mask:0xf\n\tv_mov_b32_dpp %3, %7 row_ror:15 row_mask:0xf bank_mask:0xf"
            : "=&v"(r0), "=&v"(r1), "=&v"(r2), "=&v"(r3) : "v"(x[0]), "v"(x[1]), "v"(x[2]), "v"(x[3]));
    r[0] = r0; r[1] = r1; r[2] = r2; r[3] = r3;
}
struct EpiUp {
    static constexpr bool PERM = true, AFTER_DRAIN = false;
    bf16_t* G; const float* cw; const float* cbias; int nrows; lchar* ex; lchar* wl; const StaticOrder* S;
    DI float wfetch(int pn, int idx) const {
        const int tap = idx >> 8, pos = idx & 255;
        const int ch = (pos < 128) ? (128 * pn + pos) : (DFF + 128 * pn + pos - 128);
        return (tap < 3) ? cw[tap * DFF2 + ch] : cbias[ch];
    }
    DI void operator()(const f32x4 (&acc)[2][2][4][2], const Unit& u, int wr, int wc, int fr_in, int fq_in) const {
        int fr = fr_in, fq = fq_in;
        asm volatile("" : "+v"(fr), "+v"(fq));
        const int lane = fq * 16 + fr;
        const int tid_e = (wr * 4 + wc) * 64 + lane;
        Unit nxt; const bool has_nxt = S->next(u.seq + 1, nxt);
        float wn0 = 0.f, wn1 = 0.f;
        if (has_nxt) { wn0 = wfetch(nxt.pn, tid_e); wn1 = wfetch(nxt.pn, tid_e + 512); }
        const LAS float* wlb = (const LAS float*)(wl + (u.seq & 1) * 4096);
        LAS float* exb = (LAS float*)(ex + (u.seq & 1) * 8192);
        const int qpos = 32 * wc + 8 * fq;
#pragma unroll
        for (int ai = 0; ai < 2; ++ai) {
            const int blk = 2 * ai + wr;
            if (fr == 0) {
#pragma unroll
                for (int bj = 0; bj < 2; ++bj)
#pragma unroll
                    for (int n = 0; n < 2; ++n) *(LAS f32x4*)(exb + (blk * 2 + 0) * 256 + 128 * bj + qpos + 4 * n) = acc[ai][bj][0][n];
            }
            if (fr == 15) {
#pragma unroll
                for (int bj = 0; bj < 2; ++bj)
#pragma unroll
                    for (int n = 0; n < 2; ++n) *(LAS f32x4*)(exb + (blk * 2 + 1) * 256 + 128 * bj + qpos + 4 * n) = acc[ai][bj][3][n];
            }
        }
        asm volatile("s_waitcnt lgkmcnt(0)" ::: "memory"); __builtin_amdgcn_s_barrier(); asm volatile("" ::: "memory");
        const int ch = 128 * u.pn + qpos;
#pragma unroll
        for (int ai = 0; ai < 2; ++ai) {
            const int blk = 2 * ai + wr;
            const int tr0 = 128 * ai + 64 * wr + fr;
            u32x2 pk0[4];
#pragma unroll
            for (int n = 0; n < 2; ++n) {
                f32x4 ga[4];
#pragma unroll
                for (int bj = 0; bj < 2; ++bj) {
                    const LAS float* wp = wlb + 128 * bj + qpos + 4 * n;
                    const f32x4 w0 = *(const LAS f32x4*)(wp), w1 = *(const LAS f32x4*)(wp + 256), w2 = *(const LAS f32x4*)(wp + 512), bb = *(const LAS f32x4*)(wp + 768);
                    const f32x4 eprev = *(const LAS f32x4*)(exb + (((blk + 3) & 3) * 2 + 1) * 256 + 128 * bj + qpos + 4 * n);
                    const f32x4 enext = *(const LAS f32x4*)(exb + (((blk + 1) & 3) * 2 + 0) * 256 + 128 * bj + qpos + 4 * n);
#pragma unroll
                    for (int m = 0; m < 4; ++m) {
                        const int g = 254 * u.pm - 1 + tr0 + 16 * m;
                        const int lmask = (g < NLAT) ? (T - 1) : (CL - 1);
                        const bool hp = (g & lmask) != 0, hn = ((g + 1) & lmask) != 0;
                        f32x4 sp = acc[ai][bj][m][n], sn = acc[ai][bj][m][n];
                        if (m > 0 && fr == 15) sp = acc[ai][bj][m > 0 ? m - 1 : 0][n];
                        if (m < 3 && fr == 0) sn = acc[ai][bj][m < 3 ? m + 1 : 3][n];
                        f32x4 pv, nv;
                        dpp_rot4<0>(pv, sp); dpp_rot4<1>(nv, sn);
                        if (m == 0 && fr == 0) pv = eprev;
                        if (m == 3 && fr == 15) nv = enext;
                        if (!hp) pv = (f32x4){0.f, 0.f, 0.f, 0.f};
                        if (!hn) nv = (f32x4){0.f, 0.f, 0.f, 0.f};
                        const f32x4 uu = pv * w0 + acc[ai][bj][m][n] * w1 + nv * w2 + bb;
                        if (bj == 0) { ga[m][0] = gelu_tanh(uu[0]); ga[m][1] = gelu_tanh(uu[1]); ga[m][2] = gelu_tanh(uu[2]); ga[m][3] = gelu_tanh(uu[3]); }
                        else ga[m] = ga[m] * uu;
                        asm volatile("" : "+v"(ga[m][0]), "+v"(ga[m][1]), "+v"(ga[m][2]), "+v"(ga[m][3]));
                    }
                }
#pragma unroll
                for (int m = 0; m < 4; ++m) {
                    const int tr = tr0 + 16 * m;
                    const int g = 254 * u.pm - 1 + tr;
                    u32x2 w; w.x = pack2(ga[m][0], ga[m][1]); w.y = pack2(ga[m][2], ga[m][3]);
                    if (n == 0) pk0[m] = w;
                    else if (tr >= 1 && tr <= 254 && g < nrows) {
                        u32x4 w4; w4.x = pk0[m].x; w4.y = pk0[m].y; w4.z = w.x; w4.w = w.y;
                        __builtin_nontemporal_store(w4, (u32x4*)(G + (size_t)g * DFF + ch));
                    }
                }
            }
        }
        if (has_nxt) { LAS float* wn = (LAS float*)(wl + ((u.seq + 1) & 1) * 4096); wn[tid_e] = wn0; wn[tid_e + 512] = wn1; }
    }
};

DI void phase_g1(const Params& p, int l, lchar* lds) {
    const bool even = (l & 1) == 0; const int li = l >> 1;
    Gemm g{p.H, p.wt_in(l), D, (size_t)BM * D * 2};
    StaticOrder S; S.init(NR / BM, even ? 5 : 6, gridDim.x, blockIdx.x);
    EpiIn E{p.PG, even ? 1 : 0, p.c_q_g + li * 64, p.c_k_g + li * 64};
    gemm_phase<EpiIn, StaticOrder, false, true>((LAS unsigned char*)lds, g, S, E);
}
DI void phase_gy(const Params& p, const bf16_t* A, int K, const bf16_t* Wt, int mtiles, lchar* lds) {
    Gemm g{A, Wt, K, (size_t)BM * K * 2};
    StaticOrder S; S.init(mtiles, 4, gridDim.x, blockIdx.x);
    EpiY E{p.Y};
    gemm_phase<EpiY, StaticOrder, false, true>((LAS unsigned char*)lds, g, S, E);
}
DI void phase_g3(const Params& p, int l, lchar* lds) {
    const int nrows = (l == 3) ? NLAT : NR;
    Gemm g{p.H - D, p.wt_up(l), D, (size_t)254 * D * 2};
    StaticOrder S; S.init((nrows + 253) / 254, 21, gridDim.x, blockIdx.x);
    EpiUp E{p.PG, p.ffn_conv_w + (size_t)l * 3 * DFF2, p.ffn_conv_b + (size_t)l * DFF2, nrows, lds + RING_BYTES, lds + RING_BYTES + EX_BYTES, &S};
    {
        Unit u0;
        if (S.next(0, u0)) { const int t = get_tid(); LAS float* w0p = (LAS float*)(lds + RING_BYTES + EX_BYTES); w0p[t] = E.wfetch(u0.pn, t); w0p[t + 512] = E.wfetch(u0.pn, t + 512); }
        __syncthreads();
    }
    gemm_phase<EpiUp, StaticOrder, true, true>((LAS unsigned char*)lds, g, S, E);
}

constexpr int KSTR = 144, VSTR = 192;
constexpr int KV_K = 64 * KSTR  , KV_BUF = KV_K + 64 * VSTR  ;

constexpr float ATT_THR = 8.0f;
template <int VAR>
DI void attn_unit(const bf16_t* __restrict__ Qb, int ldq, int qcol, int qrow0,
                  const bf16_t* __restrict__ Kb, const bf16_t* __restrict__ Vb, int ldkv, int kvcol,
                  int lat_row0, int nlat, int kpos0, int qpos0, bool masked,
                  int ctx_row0, int nctx, float m_init, float l_init0,
                  bf16_t* __restrict__ O, int ldo, int ocol, lchar* lds) {
    const int tid = get_tid(), lane = tid & 63, wave = tid >> 6, l31 = lane & 31, h = lane >> 5;
    const int ntiles = nlat + nctx;
    bf16x8 qf[4];
    {
        const bf16_t* qp = Qb + (size_t)(qrow0 + wave * 32 + l31) * ldq + qcol + 8 * h;
#pragma unroll
        for (int ks = 0; ks < 4; ++ks) qf[ks] = *(const bf16x8*)(qp + 16 * ks);
    }
    const int lrow = tid >> 3, lkc = tid & 7;
    auto tile_off = [&](int i) -> size_t {
        const int r0 = (i < nlat) ? (lat_row0 + 64 * i) : (ctx_row0 + 64 * (i - nlat));
        return (size_t)(r0 + lrow) * ldkv + kvcol + lkc * 8;
    };
    lchar* const Kbase = lds;
    lchar* const Vbase = lds + 2 * KV_K;
    constexpr int VB = 64 * VSTR;
    const int koff = lrow * KSTR + lkc * 16, voff = lrow * VSTR + lkc * 16;
    auto kload = [&](bf16x8 (&kf)[4][2], const lchar* Kl) {
#pragma unroll
        for (int ks = 0; ks < 4; ++ks)
#pragma unroll
            for (int kt = 0; kt < 2; ++kt) kf[ks][kt] = *(const LAS bf16x8*)(Kl + (32 * kt + l31) * KSTR + ks * 32 + h * 16);
    };
    auto qk = [&](f32x16 (&st)[2], const bf16x8 (&kf)[4][2], const f32x16& init) {
#pragma unroll
        for (int kt = 0; kt < 2; ++kt) st[kt] = MFMA32(kf[0][kt], qf[0], init);
#pragma unroll
        for (int ks = 1; ks < 4; ++ks)
#pragma unroll
            for (int kt = 0; kt < 2; ++kt) st[kt] = MFMA32(kf[ks][kt], qf[ks], st[kt]);
    };
    f32x16 negm;
    { const float z0 = opaque0();
#pragma unroll
      for (int i = 0; i < 16; ++i) negm[i] = z0; }
    const int qpos = qpos0 + wave * 32 + l31;
    auto apply_mask = [&](f32x16 (&st)[2], int it) {
        if (masked && it < nlat) {
            const int kp0 = kpos0 + 64 * it;
#pragma unroll
            for (int kt = 0; kt < 2; ++kt)
#pragma unroll
                for (int i = 0; i < 16; ++i) {
                    const int diff = qpos - (kp0 + 32 * kt + crow(i, h));
                    if (diff > 128 || diff < -128) st[kt][i] = -1e30f;
                }
        }
    };
    auto rowmax = [&](const f32x16 (&st)[2]) -> float {
        float mx = fmaxf(st[0][0], st[1][0]);
#pragma unroll
        for (int i = 1; i < 16; ++i) mx = fmaxf(mx, fmaxf(st[0][i], st[1][i]));
        return fmaxf(mx, shx(mx, 32, lane));
    };
    auto rowmax_fast = [&](const f32x16 (&st)[2]) -> float {
        float mx;
        asm("v_max3_f32 %0, %1, %2, %3" : "=v"(mx) : "v"(st[0][0]), "v"(st[0][1]), "v"(st[0][2]));
#pragma unroll
        for (int i = 3; i < 15; i += 2) asm("v_max3_f32 %0, %1, %2, %3" : "=v"(mx) : "v"(mx), "v"(st[0][i]), "v"(st[0][i + 1]));
        asm("v_max3_f32 %0, %1, %2, %3" : "=v"(mx) : "v"(mx), "v"(st[0][15]), "v"(st[1][0]));
#pragma unroll
        for (int i = 1; i < 15; i += 2) asm("v_max3_f32 %0, %1, %2, %3" : "=v"(mx) : "v"(mx), "v"(st[1][i]), "v"(st[1][i + 1]));
        asm("v_max_f32 %0, %1, %2" : "=v"(mx) : "v"(mx), "v"(st[1][15]));
        const float other = shx(mx, 32, lane);
        asm("v_max_f32 %0, %1, %2" : "=v"(mx) : "v"(mx), "v"(other));
        return mx;
    };
    {
        const u32x4 k0 = *(const u32x4*)(Kb + tile_off(0)), v0 = *(const u32x4*)(Vb + tile_off(0)), k1 = *(const u32x4*)(Kb + tile_off(1));
        *(LAS u32x4*)(Kbase + koff) = k0; *(LAS u32x4*)(Vbase + voff) = v0; *(LAS u32x4*)(Kbase + KV_K + koff) = k1;
    }
    __syncthreads();
    f32x16 o[2];
    { const float z0 = opaque0();
#pragma unroll
      for (int dt = 0; dt < 2; ++dt)
#pragma unroll
        for (int i = 0; i < 16; ++i) o[dt][i] = z0; }
    f32x16 sA[2], sB[2];
    { bf16x8 kf0[4][2]; kload(kf0, Kbase); qk(sA, kf0, negm); }
    apply_mask(sA, 0);
    float m_ref = fmaxf(m_init, rowmax(sA));
    float lsum = (h == 0) ? l_init0 * fast_exp2(m_init - m_ref) : 0.f;
#pragma unroll
    for (int kt = 0; kt < 2; ++kt)
#pragma unroll
        for (int i = 0; i < 16; ++i) sA[kt][i] -= m_ref;
#pragma unroll
    for (int i = 0; i < 16; ++i) negm[i] = -m_ref;
    auto step = [&](f32x16 (&sc)[2], f32x16 (&sn)[2], int it, u32x4& ldk, u32x4& ldv, const u32x4& stk, const u32x4& stv) {
        const int i3 = min(it + 3, ntiles - 1), i2 = min(it + 2, ntiles - 1);
        if (VAR != 4) { *(LAS u32x4*)(Kbase + (it & 1) * KV_K + koff) = stk; *(LAS u32x4*)(Vbase + ((it + 1) & 1) * VB + voff) = stv; }
        if (VAR != 4) { ldk = *(const u32x4*)(Kb + tile_off(i3)); ldv = *(const u32x4*)(Vb + tile_off(i2)); }
        bf16x8 kf[4][2]; kload(kf, Kbase + ((it + 1) & 1) * KV_K);
        const float mx = rowmax_fast(sc);
        if (__builtin_amdgcn_ballot_w64(mx > ATT_THR) != 0ull) {
            const float delta = fmaxf(mx, 0.f), alpha = fast_exp2(-delta);
#pragma unroll
            for (int dt = 0; dt < 2; ++dt)
#pragma unroll
                for (int i = 0; i < 16; ++i) o[dt][i] *= alpha;
            lsum *= alpha;
#pragma unroll
            for (int kt = 0; kt < 2; ++kt)
#pragma unroll
                for (int i = 0; i < 16; ++i) sc[kt][i] -= delta;
            m_ref += delta;
#pragma unroll
            for (int i = 0; i < 16; ++i) negm[i] = -m_ref;
        }
        if (VAR != 2) qk(sn, kf, negm); else { sn[0] = sc[0]; sn[1] = sc[1]; }
        bf16x8 vf[4][2];
        {
            const lchar* Vl = Vbase + (it & 1) * VB;
            const int qq = (lane & 15) >> 2, pp = lane & 3, g16 = (lane >> 4) & 1;
            const lchar* vb = Vl + (4 * h + qq) * VSTR + (16 * g16 + 4 * pp) * 2;
#pragma unroll
            for (int s = 0; s < 4; ++s)
#pragma unroll
                for (int dt = 0; dt < 2; ++dt) {
                    const s16x4 lo = __builtin_amdgcn_ds_read_tr16_b64_v4i16((LAS s16x4*)(vb + (16 * s) * VSTR + dt * 64));
                    const s16x4 hi = __builtin_amdgcn_ds_read_tr16_b64_v4i16((LAS s16x4*)(vb + (16 * s + 8) * VSTR + dt * 64));
                    vf[s][dt] = __builtin_shufflevector(lo, hi, 0, 1, 2, 3, 4, 5, 6, 7);
                }
        }
        float ps = 0.f;
#pragma unroll
        for (int kt = 0; kt < 2; ++kt)
#pragma unroll
            for (int i = 0; i < 16; ++i) { const float pv = (VAR == 1) ? sc[kt][i] : fast_exp2(sc[kt][i]); sc[kt][i] = pv; ps += pv; }
        lsum += ps;
        bf16x8 pf[4];
#pragma unroll
        for (int s = 0; s < 4; ++s) {
            u32x4 w;
            const int kt = s >> 1, b = 8 * (s & 1);
            w.x = pack2(sc[kt][b + 0], sc[kt][b + 1]); w.y = pack2(sc[kt][b + 2], sc[kt][b + 3]);
            w.z = pack2(sc[kt][b + 4], sc[kt][b + 5]); w.w = pack2(sc[kt][b + 6], sc[kt][b + 7]);
            pf[s] = __builtin_bit_cast(bf16x8, w);
        }
#pragma unroll
        for (int s = 0; s < 4; ++s)
#pragma unroll
            for (int dt = 0; dt < 2; ++dt) { if (VAR != 3) o[dt] = MFMA32(vf[s][dt], pf[s], o[dt]); else o[dt][s] += __builtin_bit_cast(float, (int)pf[s][dt]) + __builtin_bit_cast(float, (int)vf[s][dt][0]); }
        apply_mask(sn, it + 1);
        if (VAR != 5) __syncthreads();
    };
    u32x4 rkA, rvA, rkB, rvB;
    rkB = *(const u32x4*)(Kb + tile_off(min(2, ntiles - 1)));
    rvB = *(const u32x4*)(Vb + tile_off(1));
    for (int it = 0; it < ntiles; it += 2) { step(sA, sB, it, rkA, rvA, rkB, rvB); step(sB, sA, it + 1, rkB, rvB, rkA, rvA); }
    const float ltot = lsum + shx(lsum, 32, lane);
    const float inv = 1.0f / ltot;
    bf16_t* op = O + (size_t)(qrow0 + wave * 32 + l31) * ldo + ocol + 4 * h;
#pragma unroll
    for (int dt = 0; dt < 2; ++dt)
#pragma unroll
        for (int g = 0; g < 4; ++g) {
            u32x2 w;
            w.x = pack2(o[dt][4 * g] * inv, o[dt][4 * g + 1] * inv); w.y = pack2(o[dt][4 * g + 2] * inv, o[dt][4 * g + 3] * inv);
            *(u32x2*)(op + 32 * dt + 8 * g) = w;
        }
}

template <bool FIRST, bool MASKED>
DI void attn2_step(f32x16 (&o)[2][2], float (&m_ref)[2], float (&lsum)[2], const bf16x8 (&qf)[2][4], const lchar* Kl, const lchar* Vl, int lane, int kp0, int qw0, float m_init, float l0) {
    const int l31 = lane & 31, h = lane >> 5;
    if (MASKED && kp0 >= 0 && (kp0 + 63 < qw0 - 128 || kp0 > qw0 + 63 + 128)) {
        if (FIRST) {
#pragma unroll
            for (int q = 0; q < 2; ++q) { m_ref[q] = m_init; lsum[q] = (h == 0) ? l0 : 0.f; }
        }
        return;
    }
    bf16x8 kf[4][2];
#pragma unroll
    for (int ks = 0; ks < 4; ++ks)
#pragma unroll
        for (int kt = 0; kt < 2; ++kt) kf[ks][kt] = *(const LAS bf16x8*)(Kl + (32 * kt + l31) * KSTR + ks * 32 + h * 16);
    f32x16 sc[2][2];
#pragma unroll
    for (int q = 0; q < 2; ++q) {
        const float init = FIRST ? opaque0() : -m_ref[q];
#pragma unroll
        for (int kt = 0; kt < 2; ++kt)
#pragma unroll
            for (int i = 0; i < 16; ++i) sc[q][kt][i] = init;
#pragma unroll
        for (int ks = 0; ks < 4; ++ks)
#pragma unroll
            for (int kt = 0; kt < 2; ++kt) sc[q][kt] = MFMA32(kf[ks][kt], qf[q][ks], sc[q][kt]);
    }
    if (MASKED && kp0 >= 0 && !(kp0 >= qw0 + 63 - 128 && kp0 + 63 <= qw0 + 128)) {
#pragma unroll
        for (int q = 0; q < 2; ++q) {
            const int qpos = qw0 + q * 32 + l31;
#pragma unroll
            for (int kt = 0; kt < 2; ++kt)
#pragma unroll
                for (int i = 0; i < 16; ++i) {
                    const int diff = qpos - (kp0 + 32 * kt + crow(i, h));
                    if (diff > 128 || diff < -128) sc[q][kt][i] = -1e30f;
                }
        }
    }
    float mx[2];
#pragma unroll
    for (int q = 0; q < 2; ++q) {
        float m = fmaxf(sc[q][0][0], sc[q][1][0]);
#pragma unroll
        for (int i = 1; i < 16; ++i) m = fmaxf(m, fmaxf(sc[q][0][i], sc[q][1][i]));
        mx[q] = fmaxf(m, shx(m, 32, lane));
    }
    if (FIRST) {
#pragma unroll
        for (int q = 0; q < 2; ++q) {
            m_ref[q] = fmaxf(m_init, mx[q]);
            lsum[q] = (h == 0) ? l0 * fast_exp2(m_init - m_ref[q]) : 0.f;
#pragma unroll
            for (int kt = 0; kt < 2; ++kt)
#pragma unroll
                for (int i = 0; i < 16; ++i) sc[q][kt][i] -= m_ref[q];
        }
    } else if (__builtin_amdgcn_ballot_w64(fmaxf(mx[0], mx[1]) > ATT_THR) != 0ull) {
#pragma unroll
        for (int q = 0; q < 2; ++q) {
            const float delta = fmaxf(mx[q], 0.f), alpha = fast_exp2(-delta);
#pragma unroll
            for (int dt = 0; dt < 2; ++dt)
#pragma unroll
                for (int i = 0; i < 16; ++i) o[q][dt][i] *= alpha;
            lsum[q] *= alpha;
#pragma unroll
            for (int kt = 0; kt < 2; ++kt)
#pragma unroll
                for (int i = 0; i < 16; ++i) sc[q][kt][i] -= delta;
            m_ref[q] += delta;
        }
    }
    bf16x8 pf[2][4];
#pragma unroll
    for (int q = 0; q < 2; ++q) {
        float ps = 0.f;
#pragma unroll
        for (int kt = 0; kt < 2; ++kt)
#pragma unroll
            for (int i = 0; i < 16; ++i) { const float pv = fast_exp2(sc[q][kt][i]); sc[q][kt][i] = pv; ps += pv; }
        lsum[q] += ps;
#pragma unroll
        for (int s = 0; s < 4; ++s) {
            u32x4 w;
            const int kt = s >> 1, b = 8 * (s & 1);
            w.x = pack2(sc[q][kt][b + 0], sc[q][kt][b + 1]); w.y = pack2(sc[q][kt][b + 2], sc[q][kt][b + 3]);
            w.z = pack2(sc[q][kt][b + 4], sc[q][kt][b + 5]); w.w = pack2(sc[q][kt][b + 6], sc[q][kt][b + 7]);
            pf[q][s] = __builtin_bit_cast(bf16x8, w);
        }
    }
    {
        const int qq = (lane & 15) >> 2, pp = lane & 3, g16 = (lane >> 4) & 1;
        const lchar* vb = Vl + (4 * h + qq) * VSTR + (16 * g16 + 4 * pp) * 2;
#pragma unroll
        for (int s = 0; s < 4; ++s)
#pragma unroll
            for (int dt = 0; dt < 2; ++dt) {
                const s16x4 lo = __builtin_amdgcn_ds_read_tr16_b64_v4i16((LAS s16x4*)(vb + (16 * s) * VSTR + dt * 64));
                const s16x4 hi = __builtin_amdgcn_ds_read_tr16_b64_v4i16((LAS s16x4*)(vb + (16 * s + 8) * VSTR + dt * 64));
                const bf16x8 vf = __builtin_shufflevector(lo, hi, 0, 1, 2, 3, 4, 5, 6, 7);
#pragma unroll
                for (int q = 0; q < 2; ++q) o[q][dt] = MFMA32(vf, pf[q][s], o[q][dt]);
            }
    }
}
template <bool MASKED>
DI void attn_unit2(const bf16_t* __restrict__ Qb, int ldq, int qcol, int qrow0,
                   const bf16_t* __restrict__ Kb, const bf16_t* __restrict__ Vb, int ldkv, int kvcol,
                   int lat_row0, int nlat, int kpos0, int qpos0, int ctx_row0, int nctx, float m_init, float l0,
                   bf16_t* __restrict__ O, int ldo, int ocol, lchar* lds) {
    const int tid = get_tid(), lane = tid & 63, wave = tid >> 6, l31 = lane & 31, h = lane >> 5;
    const int ntiles = nlat + nctx;
    bf16x8 qf[2][4];
#pragma unroll
    for (int q = 0; q < 2; ++q) {
        const bf16_t* qp = Qb + (size_t)(qrow0 + wave * 64 + q * 32 + l31) * ldq + qcol + 8 * h;
#pragma unroll
        for (int ks = 0; ks < 4; ++ks) qf[q][ks] = *(const bf16x8*)(qp + 16 * ks);
    }
    const int lrow = tid >> 3, lkc = tid & 7;
    auto tile_off = [&](int i) -> size_t {
        const int r0 = (i < nlat) ? (lat_row0 + 64 * i) : (ctx_row0 + 64 * (i - nlat));
        return (size_t)(r0 + lrow) * ldkv + kvcol + lkc * 8;
    };
    lchar* const Kbase = lds; lchar* const Vbase = lds + 2 * KV_K;
    constexpr int VB = 64 * VSTR;
    const int koff = lrow * KSTR + lkc * 16, voff = lrow * VSTR + lkc * 16;
    f32x16 o[2][2];
    { const float z0 = opaque0();
#pragma unroll
      for (int q = 0; q < 2; ++q)
#pragma unroll
        for (int dt = 0; dt < 2; ++dt)
#pragma unroll
            for (int i = 0; i < 16; ++i) o[q][dt][i] = z0; }
    float m_ref[2] = {0.f, 0.f}, lsum[2] = {0.f, 0.f};
    const int qw0 = __builtin_amdgcn_readfirstlane(qpos0 + wave * 64);
    u32x4 rk, rv;
    {
        const u32x4 k0 = *(const u32x4*)(Kb + tile_off(0)), v0 = *(const u32x4*)(Vb + tile_off(0));
        rk = *(const u32x4*)(Kb + tile_off(1)); rv = *(const u32x4*)(Vb + tile_off(1));
        *(LAS u32x4*)(Kbase + koff) = k0; *(LAS u32x4*)(Vbase + voff) = v0;
    }
    __syncthreads();
    {
        *(LAS u32x4*)(Kbase + KV_K + koff) = rk; *(LAS u32x4*)(Vbase + VB + voff) = rv;
        rk = *(const u32x4*)(Kb + tile_off(2)); rv = *(const u32x4*)(Vb + tile_off(2));
        attn2_step<true, MASKED>(o, m_ref, lsum, qf, Kbase, Vbase, lane, kpos0, qw0, m_init, l0);
        __syncthreads();
    }
    for (int it = 1; it < ntiles; ++it) {
        *(LAS u32x4*)(Kbase + ((it + 1) & 1) * KV_K + koff) = rk; *(LAS u32x4*)(Vbase + ((it + 1) & 1) * VB + voff) = rv;
        const int i2 = min(it + 2, ntiles - 1);
        rk = *(const u32x4*)(Kb + tile_off(i2)); rv = *(const u32x4*)(Vb + tile_off(i2));
        attn2_step<false, MASKED>(o, m_ref, lsum, qf, Kbase + (it & 1) * KV_K, Vbase + (it & 1) * VB, lane, (it < nlat) ? kpos0 + 64 * it : -1, qw0, m_init, l0);
        __syncthreads();
    }
#pragma unroll
    for (int q = 0; q < 2; ++q) {
        const float ltot = lsum[q] + shx(lsum[q], 32, lane);
        const float inv = 1.0f / ltot;
        bf16_t* op = O + (size_t)(qrow0 + wave * 64 + q * 32 + l31) * ldo + ocol + 4 * h;
#pragma unroll
        for (int dt = 0; dt < 2; ++dt)
#pragma unroll
            for (int g = 0; g < 4; ++g) {
                u32x2 w;
                w.x = pack2(o[q][dt][4 * g] * inv, o[q][dt][4 * g + 1] * inv); w.y = pack2(o[q][dt][4 * g + 2] * inv, o[q][dt][4 * g + 3] * inv);
                *(u32x2*)(op + 32 * dt + 8 * g) = w;
            }
    }
}

constexpr int PSTR = 272;
DI void pool_unit(const Params& p, int li, int m0, int g, lchar* lds) {
    const int tid = get_tid(), lane = tid & 63, wave = tid >> 6, wm = wave & 1, wn = wave >> 1, l31 = lane & 31, h = lane >> 5;
    const bf16_t* U = p.PG;
    bf16_t* MIX = p.PG + (size_t)NR * 1536;
    int seq0, L;
    if (m0 < NLAT) { seq0 = m0 & ~(T - 1); L = T; } else { seq0 = NLAT + ((m0 - NLAT) & ~(CL - 1)); L = CL; }
    const int tl0 = m0 - seq0;
    lchar* Ur = lds;
    lchar* Dt = lds + 144 * 256;
    for (int c = tid; c < 144 * 16; c += NTHR) {
        const int j = c >> 4, ch = c & 15; const int t = tl0 - 8 + j;
        u32x4 v = (u32x4){0u, 0u, 0u, 0u};
        if (t >= 0 && t < L) v = *(const u32x4*)(U + (size_t)(seq0 + t) * 512 + g * 128 + ch * 8);
        *(LAS u32x4*)(Ur + j * 256 + ch * 16) = v;
    }
    __syncthreads();
    {
        const int hw = 1 << g;
        const int cp = tid & 63, rs = tid >> 6;
        const LAS unsigned* up = (const LAS unsigned*)Ur + cp;
        int t = tl0 + rs * 16;
        float s0 = 0.f, s1 = 0.f;
        for (int tt = t - hw; tt < t + hw; ++tt) {
            if (tt >= 0 && tt < L) { const unsigned w = up[(tt - tl0 + 8) * 64]; s0 += bf2f(w & 0xffffu); s1 += bf2f(w >> 16); }
        }
        for (int r = 0; r < 16; ++r, ++t) {
            const int lo = max(t - hw, 0), hi = min(t + hw, L);
            const float ic = 1.0f / (float)(hi - lo);
            const unsigned wc = up[(t - tl0 + 8) * 64];
            const float d0 = s0 * ic - bf2f(wc & 0xffffu), d1 = s1 * ic - bf2f(wc >> 16);
            *(LAS unsigned*)(Dt + (rs * 16 + r) * PSTR + cp * 4) = pack2(d0, d1);
            const int ta = t + hw, tr = t - hw;
            if (ta < L) { const unsigned w = up[(ta - tl0 + 8) * 64]; s0 += bf2f(w & 0xffffu); s1 += bf2f(w >> 16); }
            if (tr >= 0) { const unsigned w = up[(tr - tl0 + 8) * 64]; s0 -= bf2f(w & 0xffffu); s1 -= bf2f(w >> 16); }
        }
    }
    __syncthreads();
    f32x16 acc[2];
    { const float z0 = opaque0();
#pragma unroll
      for (int mt = 0; mt < 2; ++mt)
#pragma unroll
        for (int i = 0; i < 16; ++i) acc[mt][i] = z0; }
    const bf16_t* W = p.wt_pool(li) + (size_t)g * 128 * 128;
#pragma unroll
    for (int ks = 0; ks < 8; ++ks) {
        bf16x8 xf[2];
#pragma unroll
        for (int mt = 0; mt < 2; ++mt) xf[mt] = *(const LAS bf16x8*)(Dt + (wm * 64 + mt * 32 + l31) * PSTR + ks * 32 + h * 16);
        const bf16x8 wf = *(const bf16x8*)(W + (size_t)(wn * 32 + l31) * 128 + ks * 16 + h * 8);
#pragma unroll
        for (int mt = 0; mt < 2; ++mt) acc[mt] = MFMA32(wf, xf[mt], acc[mt]);
    }
    const float* sc = p.pool_scale + li * 512 + g * 128 + wn * 32;
#pragma unroll
    for (int mt = 0; mt < 2; ++mt) {
        const int row = m0 + wm * 64 + mt * 32 + l31;
        bf16_t* rp = MIX + (size_t)row * D + g * 128 + wn * 32 + 4 * h;
#pragma unroll
        for (int gg = 0; gg < 4; ++gg) {
            const f32x4 s4 = *(const f32x4*)(sc + 8 * gg + 4 * h);
            u32x2 w;
            w.x = pack2(acc[mt][4 * gg] * s4[0], acc[mt][4 * gg + 1] * s4[1]);
            w.y = pack2(acc[mt][4 * gg + 2] * s4[2], acc[mt][4 * gg + 3] * s4[3]);
            *(u32x2*)(rp + 8 * gg) = w;
        }
    }
    __syncthreads();
}

template <int VAR>
DI void phase_mixer(const Params& p, int l, lchar* lds) {
    const bool even = (l & 1) == 0; const int li = l >> 1;
    const bool need_ctx = l < 3;
    bf16_t* P = p.PG; bf16_t* MIX = p.PG + (size_t)NR * 1536;
    const bf16_t *Q, *Kb, *Vb; int ldq, ldkv, n_lat, n_ctx, ocol0;
    if (even) { Q = P + (size_t)NR * 512; Kb = P + (size_t)NR * 1024; Vb = P + (size_t)NR * 1152; ldq = 512; ldkv = 128; n_lat = NB * 8 * 8; n_ctx = NB * 8; ocol0 = 512; }
    else { Q = P; Kb = P + (size_t)NR * 1024; Vb = P + (size_t)NR * 1280; ldq = 1024; ldkv = 256; n_lat = NB * 4 * 8 * 4; n_ctx = need_ctx ? NB * 16 : 0; ocol0 = 0; }
    for (int id = blockIdx.x; id < n_lat + n_ctx; id += gridDim.x) {
        int hd, b, qrow0, lat_row0 = 0, nlat = 0, kpos0 = 0, qpos0 = 0; bool masked = false;
        if (id < n_lat) {
            int nb;
            if (even) {
                const int hd2 = id & 7, nb2 = (id >> 3) & 7, b2 = id >> 6, start2 = nb2 * 512;
                int kf2 = start2 - 128, kl2 = start2 + 512 + 128;
                if (kf2 < 0) kf2 = 0;
                if (kl2 > T) kl2 = T;
                attn_unit2<true>(Q, ldq, hd2 * 64, b2 * T + start2, Kb, Vb, ldkv, (hd2 >> 2) * 64, b2 * T + kf2, (kl2 - kf2) >> 6, kf2, start2, NLAT + b2 * CL, 4,
                                 p.sink_logit[li * 8 + hd2] * LOG2E, 1.0f, MIX, D, ocol0 + hd2 * 64, lds);
                continue;
            }
            else {
                const int gq = id & 3, nb2 = (id >> 2) & 7, kvh_ = (id >> 5) & 3, b2 = id >> 7, hd2 = kvh_ * 4 + gq;
                attn_unit2<false>(Q, ldq, hd2 * 64, b2 * T + nb2 * 512, Kb, Vb, ldkv, kvh_ * 64, b2 * T, 64, 0, 0, NLAT + b2 * CL, 4, -1e30f, 0.f, MIX, D, ocol0 + hd2 * 64, lds);
                continue;
            }
            const int start = nb * 256;
            qrow0 = b * T + start;
            if (even) {
                int kfirst = start - 128, klast = start + 256 + 128;
                if (kfirst < 0) kfirst = 0;
                if (klast > T) klast = T;
                nlat = (klast - kfirst) >> 6; lat_row0 = b * T + kfirst; kpos0 = kfirst; qpos0 = start; masked = true;
            } else { nlat = 64; lat_row0 = b * T; }
        } else {
            const int u = id - n_lat;
            if (even) { hd = u & 7; b = u >> 3; }
            else { hd = u & 15; b = u >> 4; }
            qrow0 = NLAT + b * CL;
        }
        const int kvh = hd >> 2;
        float m_init = -1e30f, l0 = 0.f;
        if (even) { m_init = p.sink_logit[li * 8 + hd] * LOG2E; l0 = 1.0f; }
        attn_unit<VAR>(Q, ldq, hd * 64, qrow0, Kb, Vb, ldkv, kvh * 64, lat_row0, nlat, kpos0, qpos0, masked,
                  NLAT + b * CL, 4, m_init, l0, MIX, D, ocol0 + hd * 64, lds);
    }
    if (even) {
        const int n_pool = (NR / 128) * 4;
        for (int u = (int)((blockIdx.x + (gridDim.x >> 1)) % gridDim.x); u < n_pool; u += gridDim.x) pool_unit(p, li, (u >> 2) * 128, u & 3, lds);
    }
}

struct RowBuf { f32x4 x[4]; u32x2 xb[4]; u32x2 y[4]; };
template <bool HASY, bool FROM_IN>
DI void rowop_load(RowBuf& b, const float* __restrict__ xin, const bf16_t* __restrict__ xbin, const bf16_t* __restrict__ yin, int lane) {
    if (FROM_IN) {
#pragma unroll
        for (int i = 0; i < 4; ++i) b.x[i] = __builtin_nontemporal_load((const f32x4*)(xin + (i * 64 + lane) * 4));
    } else {
#pragma unroll
        for (int i = 0; i < 4; ++i) b.xb[i] = __builtin_nontemporal_load((const u32x2*)(xbin + (i * 64 + lane) * 4));
    }
    if (HASY) {
#pragma unroll
        for (int i = 0; i < 4; ++i) b.y[i] = __builtin_nontemporal_load((const u32x2*)(yin + (i * 64 + lane) * 4));
    }
}
template <int MODE, bool FROM_IN>
DI void rowop_run(const Params& p, int l, int row0, int nrows_run, int r, int lane, bool dry = false) {
    constexpr bool HASY = MODE != 0;
    const bool last = (MODE == 2 && l == 3);
    f32x4 pa[4], pb[4], pc[4];
    {
        const float* ad = p.ada + ((size_t)l * 17 + r) * 6 * D;
        int ln, so; const float* pre;
        if (MODE == 0) { ln = 0; so = 0; pre = p.mix_pre_g; }
        else if (MODE == 1) { ln = l; so = 3; pre = p.ffn_pre_g + l * D; }
        else { ln = (l < 3) ? l + 1 : l; so = 0; pre = p.mix_pre_g + ((l < 3) ? l + 1 : l) * D; }
        const float* ad2 = p.ada + ((size_t)ln * 17 + r) * 6 * D + so * D;
        const float* gate = ad + (MODE == 1 ? 2 : 5) * D;
        const float* pg = (MODE == 1 ? p.mix_post_g : p.ffn_post_g) + l * D;
#pragma unroll
        for (int i = 0; i < 4; ++i) {
            const int c = (i * 64 + lane) * 4;
            if (HASY) pa[i] = *(const f32x4*)(gate + c) * *(const f32x4*)(pg + c);
            pb[i] = *(const f32x4*)(pre + c) * (*(const f32x4*)(ad2 + D + c) + 1.0f);
            pc[i] = *(const f32x4*)(ad2 + c);
        }
    }
    auto xptr = [&](int row) -> const float* { return row < NLAT ? p.x + (size_t)row * D : p.ctx + (size_t)(row - NLAT) * D; };
    RowBuf cur, nxt;
    rowop_load<HASY, FROM_IN>(cur, xptr(row0), p.xres + (size_t)row0 * D, p.Y + (size_t)row0 * D, lane);
    for (int j = 0; j < nrows_run; ++j) {
        const int row = row0 + j;
        if (j + 1 < nrows_run) rowop_load<HASY, FROM_IN>(nxt, xptr(row + 1), p.xres + (size_t)(row + 1) * D, p.Y + (size_t)(row + 1) * D, lane);
        f32x4 xv[4];
#pragma unroll
        for (int i = 0; i < 4; ++i) {
            if (FROM_IN) xv[i] = cur.x[i];
            else { const u32x2 w = cur.xb[i]; xv[i][0] = bf2f(w.x & 0xffffu); xv[i][1] = bf2f(w.x >> 16); xv[i][2] = bf2f(w.y & 0xffffu); xv[i][3] = bf2f(w.y >> 16); }
        }
        if (HASY) {
            f32x4 yv[4]; float ss = 0.f;
#pragma unroll
            for (int i = 0; i < 4; ++i) {
                const u32x2 w = cur.y[i];
                yv[i][0] = bf2f(w.x & 0xffffu); yv[i][1] = bf2f(w.x >> 16); yv[i][2] = bf2f(w.y & 0xffffu); yv[i][3] = bf2f(w.y >> 16);
                ss += yv[i][0] * yv[i][0] + yv[i][1] * yv[i][1] + yv[i][2] * yv[i][2] + yv[i][3] * yv[i][3];
            }
#pragma unroll
            for (int o = 32; o >= 1; o >>= 1) ss += shx(ss, o, lane);
            const float rinv = rsqrtf(ss * (1.0f / D) + EPS);
#pragma unroll
            for (int i = 0; i < 4; ++i) xv[i] = xv[i] + pa[i] * (yv[i] * rinv);
            if (last) {
#pragma unroll
                for (int i = 0; i < 4; ++i) __builtin_nontemporal_store(xv[i], (f32x4*)(p.out + (size_t)row * D + (i * 64 + lane) * 4));
            } else if (!dry) {
#pragma unroll
                for (int i = 0; i < 4; ++i) { u32x2 w; w.x = pack2(xv[i][0], xv[i][1]); w.y = pack2(xv[i][2], xv[i][3]); __builtin_nontemporal_store(w, (u32x2*)(p.xres + (size_t)row * D + (i * 64 + lane) * 4)); }
            }
        }
        if (!last) {
            float ss = 0.f;
#pragma unroll
            for (int i = 0; i < 4; ++i) ss += xv[i][0] * xv[i][0] + xv[i][1] * xv[i][1] + xv[i][2] * xv[i][2] + xv[i][3] * xv[i][3];
#pragma unroll
            for (int o = 32; o >= 1; o >>= 1) ss += shx(ss, o, lane);
            const float rinv = rsqrtf(ss * (1.0f / D) + EPS);
#pragma unroll
            for (int i = 0; i < 4; ++i) {
                const f32x4 hv = xv[i] * rinv * pb[i] + pc[i];
                u32x2 w; w.x = pack2(hv[0], hv[1]); w.y = pack2(hv[2], hv[3]);
                *(u32x2*)(p.H + (size_t)row * D + (i * 64 + lane) * 4) = w;
            }
        }
        cur = nxt;
    }
}
template <int MODE, bool FROM_IN>
DI void phase_rowop_t(const Params& p, int l, bool dry = false) {
    const int lane = get_tid() & 63, wave = get_tid() >> 6;
    const int gw = blockIdx.x * NWAVE + wave, nw = gridDim.x * NWAVE;
    const bool lat_only = (MODE == 1 && l == 3) || (MODE == 2 && l == 3);
    for (int run = gw; run < NLAT / 32; run += nw) rowop_run<MODE, FROM_IN>(p, l, run * 32, 32, run >> 7, lane, dry);
    if (!lat_only) {
        for (int run = gw; run < NCTX / 2; run += nw) rowop_run<MODE, FROM_IN>(p, l, NLAT + run * 2, 2, 16, lane, dry);
    }
}
DI void phase_rowop(const Params& p, int l, int mode) {
    if (mode == 0) phase_rowop_t<0, true>(p, l);
    else if (mode == 1) { if (l == 0) phase_rowop_t<1, true>(p, l); else phase_rowop_t<1, false>(p, l); }
    else phase_rowop_t<2, false>(p, l);
}

DI void convert_tiles(const float* __restrict__ src, int K, int N, bf16_t* __restrict__ dst, int perm_mode, int& cursor, lchar* lds) {
    const int tk = K / 64, tn = N / 64, tid = get_tid(), hf = tid >> 8, t8 = tid & 255;
    LAS float* tile = (LAS float*)lds + hf * (64 * 65);
    const int ntl = tk * tn, G_ = (int)gridDim.x;
    const int tfirst = ((int)blockIdx.x - (cursor % G_) + G_) % G_;
    cursor += ntl;
    for (int base = tfirst; base < ntl; base += 2 * G_) {
        const int t = base + hf * G_;
        const bool valid = t < ntl;
        const int ki = t / tn, ni = t % tn;
        if (valid) {
            const int r = t8 >> 4, c4 = t8 & 15;
#pragma unroll
            for (int i = 0; i < 4; ++i) {
                const f32x4 v = __builtin_nontemporal_load((const f32x4*)(src + (size_t)(ki * 64 + r + 16 * i) * N + ni * 64 + c4 * 4));
                LAS float* d = tile + (r + 16 * i) * 65 + c4 * 4;
                d[0] = v[0]; d[1] = v[1]; d[2] = v[2]; d[3] = v[3];
            }
        }
        __syncthreads();
        if (valid) {
            const int n = t8 >> 2, kq = t8 & 3;
            int drow = ni * 64 + n;
            if (perm_mode == 1) drow = 256 * (ni >> 2) + 128 * (n >> 5) + 32 * (ni & 3) + (n & 31);
            else if (perm_mode == 2) drow = (ni < 42) ? (256 * (ni >> 1) + 64 * (ni & 1) + n) : (256 * ((ni - 42) >> 1) + 128 + 64 * ((ni - 42) & 1) + n);
            u32x4 w0, w1;
            const LAS float* s = tile + (kq * 16) * 65 + n;
            w0.x = pack2(s[0 * 65], s[1 * 65]); w0.y = pack2(s[2 * 65], s[3 * 65]); w0.z = pack2(s[4 * 65], s[5 * 65]); w0.w = pack2(s[6 * 65], s[7 * 65]);
            w1.x = pack2(s[8 * 65], s[9 * 65]); w1.y = pack2(s[10 * 65], s[11 * 65]); w1.z = pack2(s[12 * 65], s[13 * 65]); w1.w = pack2(s[14 * 65], s[15 * 65]);
            bf16_t* dp = dst + (size_t)drow * K + ki * 64 + kq * 16;
            *(u32x4*)(dp) = w0; *(u32x4*)(dp + 8) = w1;
        }
        __syncthreads();
    }
}

struct CvtDesc { const float* src; bf16_t* dst; int K, N, mode, ntl; };
DI CvtDesc cvt_desc(const Params& p, int mi) {
    const int l = mi >> 3, j = mi & 7, li = l >> 1; const bool even = (l & 1) == 0;
    CvtDesc d; d.mode = 0;
    if (j == 0) { d.K = D; d.mode = 1; d.dst = p.wt_in(l); if (even) { d.src = p.ab_w_in + (size_t)li * D * AB_IN; d.N = AB_IN; } else { d.src = p.c_w_qkv + (size_t)li * D * C_IN; d.N = C_IN; } }
    else if (j == 1) { d.K = D; d.N = D; d.dst = p.wt_out(l); d.src = (even ? p.ab_w_out : p.c_w_out) + (size_t)li * D * D; }
    else if (j == 2) { d.K = D; d.N = DFF2; d.mode = 2; d.dst = p.wt_up(l); d.src = p.ffn_w_up + (size_t)l * D * DFF2; }
    else if (j == 3) { d.K = DFF; d.N = D; d.dst = p.wt_down(l); d.src = p.ffn_w_down + (size_t)l * DFF * D; }
    else { const int g = j - 4; d.K = 128; d.N = 128; d.dst = p.wt_pool(li) + (size_t)g * 128 * 128; d.src = p.pool_w + ((size_t)li * 4 + g) * 128 * 128; }
    d.ntl = (j >= 4 && !even) ? 0 : (d.K / 64) * (d.N / 64);
    return d;
}
DI void convert_all(const Params& p, lchar* lds) {
    const int tid = get_tid(), hf = tid >> 8, t8 = tid & 255;
    LAS float* tl0 = (LAS float*)lds + hf * (2 * 64 * 65);
    constexpr int TOTAL = 2 * (320 + 256 + 16 + 1344 + 672) + 2 * (384 + 256 + 1344 + 672);
    const int stride = 2 * (int)gridDim.x, hb = (int)blockIdx.x * 2 + hf;
    int mi = 0, mbase = 0; CvtDesc d = cvt_desc(p, 0);
    const int nk = (TOTAL + stride - 1) / stride;
    for (int k = 0; k < nk; k += 2) {
        f32x4 v[2][4]; bool valid[2]; int ki[2], ni[2], Kk[2], md[2]; bf16_t* dstp[2];
#pragma unroll
        for (int u = 0; u < 2; ++u) {
            const int g = hb + (k + u) * stride;
            valid[u] = g < TOTAL;
            if (valid[u]) {
                while (g >= mbase + d.ntl) { mbase += d.ntl; ++mi; d = cvt_desc(p, mi); }
                const int t = g - mbase, tn = d.N >> 6;
                ki[u] = t / tn; ni[u] = t - ki[u] * tn; Kk[u] = d.K; md[u] = d.mode; dstp[u] = d.dst;
                const int r = t8 >> 4, c4 = t8 & 15;
#pragma unroll
                for (int i = 0; i < 4; ++i) v[u][i] = __builtin_nontemporal_load((const f32x4*)(d.src + (size_t)(ki[u] * 64 + r + 16 * i) * d.N + ni[u] * 64 + c4 * 4));
            }
        }
#pragma unroll
        for (int u = 0; u < 2; ++u)
            if (valid[u]) {
                const int r = t8 >> 4, c4 = t8 & 15;
#pragma unroll
                for (int i = 0; i < 4; ++i) { LAS float* dd = tl0 + u * (64 * 65) + (r + 16 * i) * 65 + c4 * 4; dd[0] = v[u][i][0]; dd[1] = v[u][i][1]; dd[2] = v[u][i][2]; dd[3] = v[u][i][3]; }
            }
        __syncthreads();
#pragma unroll
        for (int u = 0; u < 2; ++u)
            if (valid[u]) {
                const int n = t8 >> 2, kq = t8 & 3, nn = ni[u];
                int drow = nn * 64 + n;
                if (md[u] == 1) drow = 256 * (nn >> 2) + 128 * (n >> 5) + 32 * (nn & 3) + (n & 31);
                else if (md[u] == 2) drow = (nn < 42) ? (256 * (nn >> 1) + 64 * (nn & 1) + n) : (256 * ((nn - 42) >> 1) + 128 + 64 * ((nn - 42) & 1) + n);
                u32x4 w0, w1;
                const LAS float* s = tl0 + u * (64 * 65) + (kq * 16) * 65 + n;
                w0.x = pack2(s[0 * 65], s[1 * 65]); w0.y = pack2(s[2 * 65], s[3 * 65]); w0.z = pack2(s[4 * 65], s[5 * 65]); w0.w = pack2(s[6 * 65], s[7 * 65]);
                w1.x = pack2(s[8 * 65], s[9 * 65]); w1.y = pack2(s[10 * 65], s[11 * 65]); w1.z = pack2(s[12 * 65], s[13 * 65]); w1.w = pack2(s[14 * 65], s[15 * 65]);
                bf16_t* dp = dstp[u] + (size_t)drow * Kk[u] + ki[u] * 64 + kq * 16;
                *(u32x4*)(dp) = w0; *(u32x4*)(dp + 8) = w1;
            }
        __syncthreads();
    }
}

DI void phase_prologue(const Params& p, lchar* lds) {
    const int tid = get_tid();
    if ((int)blockIdx.x < 384) {
        LAS float* sl = (LAS float*)lds;
        LAS float* red = sl + 20 * 512;
        for (int item = blockIdx.x; item < 384; item += gridDim.x) {
            const int l = item / 96, n0 = (item % 96) * 64;
            const int col = tid & 63, kq = tid >> 6;
            float a[17];
#pragma unroll
            for (int r = 0; r < 17; ++r) a[r] = 0.f;
            for (int kh = 0; kh < 2; ++kh) {
                __syncthreads();
                for (int i = tid; i < 17 * 512; i += NTHR) {
                    const int r = i >> 9, kl = i & 511, k = kh * 512 + kl;
                    const float v = (r < 16) ? p.c[r * D + k] : p.c_ctx[k];
                    sl[kl * 20 + r] = v * sigmoidf_(v);
                }
                __syncthreads();
                const float* w = p.ada_w + ((size_t)l * D + kh * 512 + kq * 64) * 6144 + n0 + col;
                for (int k = 0; k < 64; ++k) {
                    const float wv = w[(size_t)k * 6144];
                    const LAS f32x4* sp = (const LAS f32x4*)(sl + (kq * 64 + k) * 20);
                    const f32x4 s0 = sp[0], s1 = sp[1], s2 = sp[2], s3 = sp[3]; const float s16 = sl[(kq * 64 + k) * 20 + 16];
#pragma unroll
                    for (int e = 0; e < 4; ++e) { a[e] += s0[e] * wv; a[4 + e] += s1[e] * wv; a[8 + e] += s2[e] * wv; a[12 + e] += s3[e] * wv; }
                    a[16] += s16 * wv;
                }
            }
#pragma unroll
            for (int r = 0; r < 17; ++r) red[(kq * 17 + r) * 64 + col] = a[r];
            __syncthreads();
            for (int i = tid; i < 17 * 64; i += NTHR) {
                const int r = i >> 6, cc = i & 63;
                float v = p.ada_b[l * 6144 + n0 + cc];
#pragma unroll
                for (int q8 = 0; q8 < 8; ++q8) v += red[(q8 * 17 + r) * 64 + cc];
                p.ada[((size_t)l * 17 + r) * 6144 + n0 + cc] = v;
            }
            __syncthreads();
        }
    }
    __syncthreads();
    convert_all(p, lds);
}

#define XB_TMO      128
#define XB_XCNT(j)  (256  + 64 * (j))
#define XB_XSUB(j)  (1280 + 64 * (j))
#define XB_XGEN(j)  (2304 + 64 * (j))
#define XB_TOP      3328
#define XB_TOPGEN   3392
#define XCD_BAR_WORDS 3456
#define XB_SPIN_CAP (1u << 18)

__device__ __forceinline__ unsigned xb_ld(unsigned* p)              { return __hip_atomic_load(p, __ATOMIC_RELAXED, __HIP_MEMORY_SCOPE_AGENT); }
__device__ __forceinline__ unsigned xb_add(unsigned* p, unsigned v) { return __hip_atomic_fetch_add(p, v, __ATOMIC_RELAXED, __HIP_MEMORY_SCOPE_AGENT); }
__device__ __forceinline__ unsigned xb_xcc_id() { return (unsigned)__builtin_amdgcn_s_getreg((3 << 11) | 20) & 0xFu; }
#define XB_SPIN(cond, bar) do { unsigned _sp = 0; while (cond) { __builtin_amdgcn_s_sleep(1); \
    if ((++_sp & 255u) == 0u) { if (xb_ld(&(bar)[XB_TMO])) break; if (_sp > XB_SPIN_CAP) { atomicAdd(&(bar)[XB_TMO], 1u); break; } } } } while (0)

struct XcdBarrier {
    unsigned* bar; unsigned x;
    volatile LAS unsigned* st;
};

__device__ __forceinline__ XcdBarrier xcd_barrier_post(unsigned* bar, volatile LAS unsigned* st) {
    XcdBarrier b; b.bar = bar; b.x = xb_xcc_id(); b.st = st;
    if (threadIdx.x == 0) (void)xb_add(&bar[XB_XCNT(b.x)], 1u);
    return b;
}
__device__ __forceinline__ void xcd_barrier_complete(unsigned* bar, unsigned x, unsigned& nloc, unsigned& nx) {
    const unsigned G = gridDim.x * gridDim.y * gridDim.z;
    unsigned sum, cnt, mine, sp = 0u;
    for (;;) {
        sum = 0u; cnt = 0u; mine = 0u;
#pragma unroll
        for (unsigned j = 0; j < 16; ++j) { const unsigned c = xb_ld(&bar[XB_XCNT(j)]); sum += c; cnt += (c > 0u) ? 1u : 0u; mine = (j == x) ? c : mine; }
        if (sum == G) break;
        __builtin_amdgcn_s_sleep(1);
        if ((++sp & 255u) == 0u) { if (xb_ld(&bar[XB_TMO])) break; if (sp > XB_SPIN_CAP) { atomicAdd(&bar[XB_TMO], 1u); break; } }
    }
    nloc = mine > 0u ? mine : 1u; nx = cnt > 0u ? cnt : 1u;
}

__device__ __forceinline__ void xcd_barrier(const XcdBarrier& b) {
    asm volatile("s_waitcnt vmcnt(0)" ::: "memory");
    __syncthreads();
    if (threadIdx.x == 0) {
        unsigned* bar = b.bar;
        __builtin_amdgcn_s_waitcnt(0);
        unsigned nloc = b.st[0], nx = b.st[1];
        if (nloc == 0u) { xcd_barrier_complete(bar, b.x, nloc, nx); b.st[0] = nloc; b.st[1] = nx; }
        const unsigned old = xb_add(&bar[XB_XSUB(b.x)], 1u);
        const unsigned gen = old / nloc;
        if (old + 1u == (gen + 1u) * nloc) {
            __builtin_amdgcn_fence(__ATOMIC_RELEASE, "agent");
            asm volatile("s_waitcnt vmcnt(0)" ::: "memory");
            const unsigned og = xb_add(&bar[XB_TOP], 1u);
            const unsigned tg = og / nx;
            if (og + 1u == (tg + 1u) * nx) xb_add(&bar[XB_TOPGEN], 1u);
            else XB_SPIN(xb_ld(&bar[XB_TOPGEN]) == tg, bar);
            __builtin_amdgcn_fence(__ATOMIC_ACQUIRE, "agent");
            xb_add(&bar[XB_XGEN(b.x)], 1u);
            asm volatile("s_waitcnt vmcnt(0)" ::: "memory");
        } else {
            XB_SPIN(xb_ld(&bar[XB_XGEN(b.x)]) == gen, bar);
            __builtin_amdgcn_fence(__ATOMIC_ACQUIRE, "agent");
            asm volatile("s_waitcnt vmcnt(0)" ::: "memory");
        }
    }
    __syncthreads();
}

DI void run_phase(const Params& p, int ph, lchar* lds) {
#ifdef ONLY
    if (ONLY == 0) { phase_prologue(p, lds); return; }
    if (ONLY == 1) { phase_rowop(p, ph & 3, ph % 3); return; }
    if (ONLY == 2) { phase_g1(p, ph & 3, lds); return; }
    if (ONLY == 3) { phase_mixer<0>(p, ph & 3, lds); return; }
    if (ONLY == 4) { phase_gy(p, p.PG, DFF, p.wt_down(ph & 3), NR / BM, lds); return; }
    if (ONLY == 5) { phase_g3(p, ph & 3, lds); return; }
    return;
#endif
    if (ph == 0) { phase_prologue(p, lds); if (PROBE_DUP == 5) { __syncthreads(); phase_prologue(p, lds); } return; }
    if (ph == 1) { phase_rowop(p, 0, 0); return; }
    const int q = ph - 2, l = q / 7, s = q % 7;
    const int reps = (((PROBE_DUP == 1 || PROBE_DUP >= 10) && s == 1 && (l & 1)) || (PROBE_DUP == 2 && (s == 0 || s == 2 || s == 4 || s == 5)) || (PROBE_DUP == 3 && s == 1 && !(l & 1)) || (PROBE_DUP == 4 && s == 4)) ? 2 : 1;
    for (int rep = 0; rep < reps; ++rep) {
        if (rep) __syncthreads();
        switch (s) {
            case 0: phase_g1(p, l, lds); break;
            case 1: if (PROBE_DUP >= 10 && rep == 0 && reps == 2) phase_mixer<(PROBE_DUP >= 10 ? PROBE_DUP - 10 : 0)>(p, l, lds); else phase_mixer<0>(p, l, lds); break;
            case 2: phase_gy(p, p.PG + (size_t)NR * 1536, D, p.wt_out(l), (l == 3) ? NLAT / BM : NR / BM, lds); break;
            case 3: phase_rowop(p, l, 1); break;
            case 4: phase_g3(p, l, lds); break;
            case 5: phase_gy(p, p.PG, DFF, p.wt_down(l), (l == 3) ? NLAT / BM : NR / BM, lds); break;
            default: phase_rowop(p, l, 2); break;
        }
    }
}

__global__ void __launch_bounds__(NTHR, 2) fwd_megakernel(Params p) {
    __shared__ __attribute__((aligned(16))) char smem[LDS_BYTES];
    __shared__ __attribute__((aligned(16))) unsigned xb_words[4];
    lchar* lds = (lchar*)smem;
    if (threadIdx.x < 4) xb_words[threadIdx.x] = 0u;
    __syncthreads();
    XcdBarrier xb = xcd_barrier_post(p.bar, (volatile LAS unsigned*)xb_words);
    for (int ph = p.ph_lo; ph < p.ph_hi; ++ph) {
        run_phase(p, ph, lds);
        if (ph + 1 < p.ph_hi) {
            if (p.ph_hi < 0) cg::this_grid().sync();
            xcd_barrier(xb);
            if (PROBE_DUP == 6) { xcd_barrier(xb); xcd_barrier(xb); }
        }
    }
}

extern "C" void kernel_launch(void* const* d_in, const int* in_sizes, int n_in, void* d_out, int out_size, void* d_ws, size_t ws_size,
                              hipStream_t stream) {
    static int grid_blocks = 0;
    if (!grid_blocks) {
        int dev = 0, cus = 0, per_cu = 0;
        hipGetDevice(&dev);
        hipDeviceGetAttribute(&cus, hipDeviceAttributeMultiprocessorCount, dev);
        hipOccupancyMaxActiveBlocksPerMultiprocessor(&per_cu, fwd_megakernel, NTHR, 0);
        per_cu = 1;
        grid_blocks = cus * per_cu;
    }
    Params p;
    memset(&p, 0, sizeof(p));
    const float* const* in = (const float* const*)d_in;
    p.x = in[0]; p.c = in[1]; p.ctx = in[2]; p.c_ctx = in[3]; p.ada_w = in[4]; p.ada_b = in[5];
    p.mix_pre_g = in[6]; p.mix_post_g = in[7]; p.ffn_pre_g = in[8]; p.ffn_post_g = in[9];
    p.ab_w_in = in[10]; p.ab_w_out = in[11]; p.pool_w = in[12]; p.pool_scale = in[13]; p.sink_logit = in[14];
    p.c_w_qkv = in[15]; p.c_w_out = in[16]; p.c_q_g = in[17]; p.c_k_g = in[18];
    p.ffn_w_up = in[19]; p.ffn_conv_w = in[20]; p.ffn_conv_b = in[21]; p.ffn_w_down = in[22];
    p.out = (float*)d_out;
    char* w = (char*)d_ws; size_t off = 0;
    auto take = [&](size_t bytes) { char* r = w + off; off += (bytes + 255) & ~(size_t)255; return r; };
    p.xres = (bf16_t*)take((size_t)NR * D * 2);
    p.H = (bf16_t*)take((size_t)NR * D * 2);
    p.Y = (bf16_t*)take((size_t)NR * D * 2);
    p.PG = (bf16_t*)take((size_t)NR * DFF * 2);
    p.ada = (float*)take((size_t)4 * 17 * 6144 * 4);
    p.bar = (unsigned*)take((size_t)XCD_BAR_WORDS * 4);
    p.wt_in_b = (bf16_t*)take((size_t)4 * C_IN * D * 2);
    p.wt_out_b = (bf16_t*)take((size_t)4 * D * D * 2);
    p.wt_up_b = (bf16_t*)take((size_t)4 * DFF2 * D * 2);
    p.wt_down_b = (bf16_t*)take((size_t)4 * D * DFF * 2);
    p.wt_pool_b = (bf16_t*)take((size_t)2 * 4 * 128 * 128 * 2);
    if (off > ws_size) { fprintf(stderr, "workspace too small: need %zu have %zu\n", off, ws_size); return; }
#if MULTI_LAUNCH
    for (int ph = 0; ph < NPHASE; ++ph) {
        p.ph_lo = ph; p.ph_hi = ph + 1;
        hipLaunchKernelGGL(fwd_megakernel, dim3(grid_blocks), dim3(NTHR), 0, stream, p);
    }
#else
    p.ph_lo = 0; p.ph_hi = NPHASE;
    hipMemsetAsync(p.bar, 0, (size_t)XCD_BAR_WORDS * 4, stream);
    void* args[] = {&p};
    hipError_t e = hipLaunchCooperativeKernel((void*)fwd_megakernel, dim3(grid_blocks), dim3(NTHR), args, 0, stream);
    if (e != hipSuccess) fprintf(stderr, "cooperative launch failed: %s (grid %d)\n", hipGetErrorString(e), grid_blocks);
#endif
}
```
